# Optimizing an MI355X kernel written in HIP

```python
import math
import jax, jax.numpy as jnp
from jax import lax
import numpy as np

D_MODEL = 1024
BATCH = 8
SEQ = 2048
DEPTH = 1
DEC_BATCH = 128
DEC_SEQ = 1
PAST_LEN = 16384
PAGE_SIZE = 128

EPS = 1e-6
D_LRU = D_MODEL
LRU_BLOCKS = 8
LRU_BW = D_LRU // LRU_BLOCKS
LRU_C = 8.0
CONV_W = 4
GLA_HEADS = 4
GLA_DV = D_MODEL // GLA_HEADS
GLA_DK = GLA_DV // 2
GLA_RANK = 16
GLA_TAU = 16.0
GLA_CHUNK = 64
D_GLA = GLA_HEADS * GLA_DV
D_MIX = D_LRU + D_GLA
IN_SIZES = (D_LRU, D_LRU, GLA_HEADS * GLA_DK, GLA_HEADS * GLA_DK, D_GLA, GLA_RANK, D_GLA)
D_IN = sum(IN_SIZES)
SPLITS = [int(s) for s in np.cumsum(IN_SIZES)[:-1]]

kernel_name = "hymba_rglru_gla_adaln_step"


def _rmsnorm(x, g):
    xf = x.astype(jnp.float32)
    y = xf * lax.rsqrt(jnp.mean(xf * xf, axis=-1, keepdims=True) + EPS)
    return (y * g.astype(jnp.float32)).astype(x.dtype)


def _lin_comb(left, right):
    a1, b1 = left
    a2, b2 = right
    return a1 * a2, a2 * b1 + b2


def _gla_chunked(q, k, v, g, S0):
    Bn, T, H, K = q.shape
    V = v.shape[-1]
    C = min(GLA_CHUNK, T)
    n = -(-T // C)
    pad = n * C - T
    padw = ((0, 0), (0, pad), (0, 0), (0, 0))
    q, k, v, g = (jnp.pad(t, padw) for t in (q, k, v, g))
    def blk(t):
        return t.reshape(Bn, n, C, H, t.shape[-1]).transpose(1, 0, 3, 2, 4)
    q, k, v, g = blk(q), blk(k), blk(v), blk(g)
    b = jnp.cumsum(g, axis=3)
    b_last = b[:, :, :, -1:, :]
    q_in = q * jnp.exp(b)
    k_in = k * jnp.exp(-b)
    k_dec = k * jnp.exp(b_last - b)
    mask = jnp.tril(jnp.ones((C, C), dtype=bool))
    A = jnp.einsum('nbhck,nbhsk->nbhcs', q_in, k_in)
    A = jnp.where(mask, A, 0.0)
    o_intra = jnp.einsum('nbhcs,nbhsv->nbhcv', A, v)

    def step(S, xs):
        qn, kn, vn, dl = xs
        o = jnp.einsum('bhck,bhkv->bhcv', qn, S)
        S = jnp.exp(dl[:, :, 0, :])[..., None] * S + jnp.einsum('bhck,bhcv->bhkv', kn, vn)
        return S, o

    S_fin, o_inter = lax.scan(step, S0, (q_in, k_dec, v, b_last))
    o = (o_intra + o_inter).transpose(1, 0, 3, 2, 4).reshape(Bn, n * C, H, V)[:, :T]
    return o, S_fin


def _layer(x, c, h0, conv0, S0, g_norm, w_ada, b_ada, w_in, conv_w, conv_b,
           w_gate_x, b_gate_x, w_gate_a, b_gate_a, lru_lambda,
           w_gla_g2, b_gla_g2, g_gla_norm, w_out):
    Bn, T, _ = x.shape
    f32 = jnp.float32
    ada = jax.nn.silu(c) @ w_ada + b_ada
    shift, scale, gate = jnp.split(ada, 3, axis=-1)
    hn = _rmsnorm(x, g_norm) * (1.0 + scale[:, None]) + shift[:, None]
    z = hn @ w_in
    xa, za, q, k, v, glr, zg = jnp.split(z, SPLITS, axis=-1)

    xp = jnp.concatenate([conv0.astype(xa.dtype), xa], axis=1)
    xc = conv_b + sum(xp[:, j:j + T] * conv_w[j] for j in range(CONV_W))
    new_conv = xp[:, T:]
    xb = xc.reshape(Bn, T, LRU_BLOCKS, LRU_BW)
    gx = jax.nn.sigmoid(jnp.einsum('btnd,nde->btne', xb, w_gate_x).reshape(Bn, T, D_LRU) + b_gate_x)
    ga = jax.nn.sigmoid(jnp.einsum('btnd,nde->btne', xb, w_gate_a).reshape(Bn, T, D_LRU) + b_gate_a)
    log_a = (LRU_C * ga.astype(f32)) * jax.nn.log_sigmoid(lru_lambda.astype(f32))
    a = jnp.exp(log_a)
    mult = jnp.sqrt(-jnp.expm1(2.0 * log_a))
    u = mult * (gx * xc).astype(f32)
    u = u.at[:, 0].add(a[:, 0] * h0.astype(f32))
    _, h = lax.associative_scan(_lin_comb, (a, u), axis=1)
    y_lru = h.astype(x.dtype) * jax.nn.silu(za)

    qh = q.reshape(Bn, T, GLA_HEADS, GLA_DK).astype(f32) * (GLA_DK ** -0.5)
    kh = k.reshape(Bn, T, GLA_HEADS, GLA_DK).astype(f32)
    vh = v.reshape(Bn, T, GLA_HEADS, GLA_DV).astype(f32)
    log_alpha = jax.nn.log_sigmoid((glr @ w_gla_g2 + b_gla_g2).astype(f32)) / GLA_TAU
    log_alpha = log_alpha.reshape(Bn, T, GLA_HEADS, GLA_DK)
    o, S_new = _gla_chunked(qh, kh, vh, log_alpha, S0.astype(f32))
    o = o * lax.rsqrt(jnp.mean(o * o, axis=-1, keepdims=True) + EPS) * g_gla_norm.astype(f32)
    y_gla = o.reshape(Bn, T, D_GLA).astype(x.dtype) * jax.nn.silu(zg)

    mix = jnp.concatenate([y_lru, y_gla], axis=-1) @ w_out
    x = x + gate[:, None] * mix
    return x, h[:, -1], new_conv, S_new


def setup_inputs(seed: int = 0) -> dict:
    key = jax.random.key(seed)
    ks = jax.random.split(key, 24)
    nrm = lambda k, s, sc: jax.random.normal(k, s, jnp.float32) * sc
    u = jax.random.uniform(ks[14], (DEPTH, D_LRU), jnp.float32, 0.9, 0.999)
    s = u ** (1.0 / LRU_C)
    lru_lambda = jnp.log(s) - jnp.log1p(-s)
    return {
        "x_prompt": nrm(ks[0], (BATCH, SEQ, D_MODEL), 1.0),
        "x_sample": nrm(ks[1], (DEC_BATCH, DEC_SEQ, D_MODEL), 1.0),
        "state_lru_h": nrm(ks[2], (DEPTH, DEC_BATCH, D_LRU), 0.5),
        "state_lru_conv": nrm(ks[3], (DEPTH, DEC_BATCH, CONV_W - 1, D_LRU), 1.0),
        "state_gla": nrm(ks[4], (DEPTH, DEC_BATCH, GLA_HEADS, GLA_DK, GLA_DV), 1.0),
        "c_prompt": nrm(ks[5], (BATCH, D_MODEL), 1.0),
        "c_sample": nrm(ks[6], (DEC_BATCH, D_MODEL), 1.0),
        "g_norm": 1.0 + nrm(ks[7], (DEPTH, D_MODEL), 0.02),
        "w_ada": nrm(ks[8], (DEPTH, D_MODEL, 3 * D_MODEL), 0.5 * D_MODEL ** -0.5),
        "b_ada": nrm(ks[9], (DEPTH, 3 * D_MODEL), 0.02),
        "w_in": nrm(ks[10], (DEPTH, D_MODEL, D_IN), D_MODEL ** -0.5),
        "conv_w": nrm(ks[11], (DEPTH, CONV_W, D_LRU), CONV_W ** -0.5),
        "conv_b": nrm(ks[12], (DEPTH, D_LRU), 0.02),
        "w_gate_x": nrm(ks[13], (DEPTH, LRU_BLOCKS, LRU_BW, LRU_BW), LRU_BW ** -0.5),
        "b_gate_x": nrm(ks[15], (DEPTH, D_LRU), 0.02),
        "w_gate_a": nrm(ks[16], (DEPTH, LRU_BLOCKS, LRU_BW, LRU_BW), LRU_BW ** -0.5),
        "b_gate_a": nrm(ks[17], (DEPTH, D_LRU), 0.02),
        "lru_lambda": lru_lambda,
        "w_gla_g2": nrm(ks[18], (DEPTH, GLA_RANK, GLA_HEADS * GLA_DK), GLA_RANK ** -0.5),
        "b_gla_g2": nrm(ks[19], (DEPTH, GLA_HEADS * GLA_DK), 0.02),
        "g_gla_norm": 1.0 + nrm(ks[20], (DEPTH, GLA_HEADS, GLA_DV), 0.02),
        "w_out": nrm(ks[21], (DEPTH, D_MIX, D_MODEL), D_MIX ** -0.5),
        "g_final": 1.0 + nrm(ks[22], (D_MODEL,), 0.02),
    }


def reference(x_prompt, x_sample, state_lru_h, state_lru_conv, state_gla, c_prompt, c_sample,
              g_norm, w_ada, b_ada, w_in, conv_w, conv_b, w_gate_x, b_gate_x, w_gate_a, b_gate_a,
              lru_lambda, w_gla_g2, b_gla_g2, g_gla_norm, w_out, g_final):
    bp = x_prompt.shape[0]
    yp, ys = x_prompt, x_sample
    hp_l, cp_l, sp_l, hs_l, cs_l, ss_l = [], [], [], [], [], []
    for l in range(DEPTH):
        w = (g_norm[l], w_ada[l], b_ada[l], w_in[l], conv_w[l], conv_b[l],
             w_gate_x[l], b_gate_x[l], w_gate_a[l], b_gate_a[l], lru_lambda[l],
             w_gla_g2[l], b_gla_g2[l], g_gla_norm[l], w_out[l])
        h0 = jnp.zeros((bp, D_LRU), jnp.float32)
        conv0 = jnp.zeros((bp, CONV_W - 1, D_LRU), x_prompt.dtype)
        S0 = jnp.zeros((bp, GLA_HEADS, GLA_DK, GLA_DV), jnp.float32)
        yp, hp, cp, sp = _layer(yp, c_prompt, h0, conv0, S0, *w)
        ys, hs, cs, ss = _layer(ys, c_sample, state_lru_h[l], state_lru_conv[l], state_gla[l], *w)
        hp_l.append(hp); cp_l.append(cp); sp_l.append(sp)
        hs_l.append(hs); cs_l.append(cs); ss_l.append(ss)
    yp = _rmsnorm(yp, g_final)
    ys = _rmsnorm(ys, g_final)
    return (yp, ys, jnp.stack(hp_l), jnp.stack(cp_l), jnp.stack(sp_l),
            jnp.stack(hs_l), jnp.stack(cs_l), jnp.stack(ss_l))
```

```cpp
#include <hip/hip_runtime.h>
#include <hip/hip_cooperative_groups.h>
#include <cstdio>
#include <cstdint>
#include <cstring>
namespace cg = cooperative_groups;

namespace pg8 {
#define PG8_LAS __attribute__((address_space(3)))
typedef unsigned short bf16_t;
typedef short bf16x8 __attribute__((ext_vector_type(8)));
typedef float f32x4 __attribute__((ext_vector_type(4)));
typedef unsigned u32x4 __attribute__((ext_vector_type(4)));
constexpr int BM = 256, BK = 64, HALF = 128, HTB = HALF * BK * 2  , STAGE_BYTES = 8 * HTB, NXCD = 8, WGM = 8;

__host__ __device__ __forceinline__ int lds_byte(int r, int c) { const int st = (r >> 4) * 2 + (c >> 5), rr = r & 15, cc = c & 31, ob = rr * 64 + cc * 2; return st * 1024 + (ob ^ (((ob >> 9) & 1) << 5)); }
__host__ __device__ __forceinline__ void stage_rc(int b, int& R, int& C) { const int st = b / 1024, sb = b % 1024, swz = sb ^ (((sb >> 9) & 1) << 5); R = (st >> 1) * 16 + swz / 64; C = (st & 1) * 32 + (swz % 64) / 2; }
__host__ __device__ __forceinline__ int perm32(int rho) { const int n = rho >> 4, i = rho & 15; return 8 * (i >> 2) + 4 * n + (i & 3); }

struct Unit { int pm, pn; };
struct Gemm { const bf16_t* A; const bf16_t* Bt; int M, N, K; int skip_pn, skip_rows; };

struct StaticOrder {
    int nM, nN, nwg, G, c;
    __host__ __device__ void init(int M, int N, int G_, int c_) { nM = M / BM; nN = N / BM; nwg = nM * nN; G = G_; c = c_; }
    __host__ __device__ bool next(int i, Unit& u) const {
        const long L = (long)i * G + c; if (L >= nwg) return false;
        int wgid = (int)L; { const int q = nwg / NXCD, r = nwg % NXCD, xcd = wgid % NXCD, off = wgid / NXCD; wgid = (xcd < r ? xcd * (q + 1) : r * (q + 1) + (xcd - r) * q) + off; }
        const int nig = WGM * nN, gid = wgid / nig, fm = gid * WGM, gsz = (nM - fm) < WGM ? (nM - fm) : WGM;
        u.pm = fm + ((wgid % nig) % gsz); u.pn = (wgid % nig) / gsz; return true;
    }
    __device__ __forceinline__ void a_ready(const Unit&) const {}
    __device__ __forceinline__ void done(const Unit&) const {}
};
__device__ __forceinline__ unsigned cvt_pk_bf16(float lo, float hi) { unsigned r; asm volatile("v_cvt_pk_bf16_f32 %0, %1, %2" : "=v"(r) : "v"(lo), "v"(hi)); return r; }
template <class Epi, class Sched, bool STAMP = false>
__device__ __forceinline__ void gemm_phase(PG8_LAS unsigned char* lds, const Gemm g, const Sched& S, const Epi& E, unsigned long long* stamps) {
    const int tid = threadIdx.x, wid = __builtin_amdgcn_readfirstlane(tid >> 6), lane = tid & 63, wr = wid >> 2, wc = wid & 3, fr = lane & 15, fq = lane >> 4;
    const int K = g.K, nt = K / BK;
    int ts_lo = 0, ts_hi = 0, nts = 0; const unsigned long long rt_entry = STAMP ? (unsigned long long)wall_clock64() : 0ull;
#define PG8_STAMP() do { if (STAMP && wid == 0 && nts < 64) { const unsigned long long _c = (unsigned long long)clock64(); \
        ts_lo = (lane == nts) ? (int)(unsigned)_c : ts_lo; ts_hi = (lane == nts) ? (int)(unsigned)(_c >> 32) : ts_hi; ++nts; } } while (0)
    PG8_STAMP();
    unsigned voffA[2], voffB[2];
#pragma unroll
    for (int i = 0; i < 2; ++i) { int R, C; stage_rc(tid * 16 + i * 8192, R, C); const int Rb = Epi::PERM ? ((R & ~31) + perm32(R & 31)) : R;
        voffA[i] = (unsigned)(R * K + C) * 2u; voffB[i] = (unsigned)(Rb * K + C) * 2u; }
    const size_t kstep = (size_t)(BK * 2);
    const size_t hstep = (size_t)HALF * K * 2;
    const size_t tstep = 2 * hstep;
    const unsigned ldsw = (unsigned)wid * 1024u;
    const int aoff = lds_byte(wr * 64 + fr, fq * 8), boff = lds_byte(wc * 32 + fr, fq * 8);
#define PG8_SA(b, h) (((b) * 2 + (h)) * HTB)
#define PG8_SB(b, h) ((4 + (b) * 2 + (h)) * HTB)
#define PG8_STAGE(bufoff, gbase, voff) do { _Pragma("unroll") for (int _i = 0; _i < 2; ++_i) \
        __builtin_amdgcn_global_load_lds((const unsigned*)((const char*)(gbase) + (voff)[_i]), (PG8_LAS unsigned*)(lds + (bufoff) + ldsw + _i * 8192), 16, 0, 0); } while (0)
#define PG8_LDA(dst, b, h) do { _Pragma("unroll") for (int m = 0; m < 4; ++m) _Pragma("unroll") for (int k = 0; k < 2; ++k) dst[m][k] = *(const PG8_LAS bf16x8*)(lds + PG8_SA(b, h) + aoff + m * 2048 + k * 1024); } while (0)
#define PG8_LDB(dst, b, h) do { _Pragma("unroll") for (int n = 0; n < 2; ++n) _Pragma("unroll") for (int k = 0; k < 2; ++k) dst[n][k] = *(const PG8_LAS bf16x8*)(lds + PG8_SB(b, h) + boff + n * 2048 + k * 1024); } while (0)
#define PG8_MMA(ai, bj, At, Bt) do { __builtin_amdgcn_s_setprio(1); _Pragma("unroll") for (int m = 0; m < 4; ++m) _Pragma("unroll") for (int n = 0; n < 2; ++n) _Pragma("unroll") for (int k = 0; k < 2; ++k) \
        acc[ai][bj][m][n] = __builtin_amdgcn_mfma_f32_16x16x32_bf16(Bt[n][k], At[m][k], acc[ai][bj][m][n], 0, 0, 0); __builtin_amdgcn_s_setprio(0); } while (0)
#define PG8_WAIT_V(n) asm volatile("s_waitcnt vmcnt(" #n ")" ::: "memory")
#define PG8_WAIT_L(n) asm volatile("s_waitcnt lgkmcnt(" #n ")" ::: "memory")
#define PG8_BAR __builtin_amdgcn_s_barrier()
#define PG8_SCHED __builtin_amdgcn_sched_barrier(0)
    Unit cur, nxt; int ui = 0;
    if (!S.next(0, cur)) return;
    f32x4 acc[2][2][4][2];
#pragma unroll
    for (int a = 0; a < 2; ++a)
#pragma unroll
        for (int b = 0; b < 2; ++b)
#pragma unroll
            for (int m = 0; m < 4; ++m)
#pragma unroll
                for (int n = 0; n < 2; ++n) acc[a][b][m][n] = (f32x4){0.f, 0.f, 0.f, 0.f};
    bf16x8 At[4][2], B0[2][2], B1[2][2];
    const char* cA = (const char*)g.A + (size_t)cur.pm * tstep; const char* cB = (const char*)g.Bt + (size_t)cur.pn * tstep + (cur.pn >= g.skip_pn ? (size_t)g.skip_rows * K * 2 : (size_t)0);
    S.a_ready(cur);
    PG8_STAGE(PG8_SB(0, 0), cB, voffB); PG8_STAGE(PG8_SA(0, 0), cA, voffA); PG8_STAGE(PG8_SB(0, 1), cB + hstep, voffB); PG8_STAGE(PG8_SA(0, 1), cA + hstep, voffA);
    if (wr == 1) PG8_BAR;
    PG8_WAIT_V(4); PG8_BAR;
    PG8_STAGE(PG8_SB(1, 0), cB + kstep, voffB); PG8_STAGE(PG8_SA(1, 0), cA + kstep, voffA); PG8_STAGE(PG8_SB(1, 1), cB + hstep + kstep, voffB);
    PG8_WAIT_V(6); PG8_BAR;
    PG8_STAMP();
    for (;;) {
        const bool has_next = S.next(ui + 1, nxt);
        const char* nA = has_next ? (const char*)g.A + (size_t)nxt.pm * tstep : cA; const char* nB = has_next ? (const char*)g.Bt + (size_t)nxt.pn * tstep + (nxt.pn >= g.skip_pn ? (size_t)g.skip_rows * K * 2 : (size_t)0) : cB;
        for (int t = 0; t < nt; t += 2) {
            const bool last = (t == nt - 2);
            const char* a1 = cA + (size_t)(t + 1) * kstep;
            const char* a2 = last ? nA : cA + (size_t)(t + 2) * kstep; const char* b2 = last ? nB : cB + (size_t)(t + 2) * kstep;
            const char* a3 = a2 + kstep; const char* b3 = b2 + kstep;
            if (last && has_next) S.a_ready(nxt);
            PG8_LDB(B0, 0, 0); PG8_SCHED; PG8_LDA(At, 0, 0); PG8_STAGE(PG8_SA(1, 1), a1 + hstep, voffA);
            PG8_WAIT_L(8); PG8_BAR; PG8_WAIT_L(0); PG8_MMA(0, 0, At, B0); PG8_BAR; PG8_SCHED;
            PG8_LDB(B1, 0, 1); PG8_STAGE(PG8_SB(0, 0), b2, voffB);
            PG8_BAR; PG8_WAIT_L(0); PG8_MMA(0, 1, At, B1); PG8_BAR;
            PG8_LDA(At, 0, 1); PG8_STAGE(PG8_SA(0, 0), a2, voffA);
            PG8_BAR; PG8_WAIT_L(0); PG8_MMA(1, 0, At, B0); PG8_BAR; PG8_SCHED;
            PG8_STAGE(PG8_SB(0, 1), b2 + hstep, voffB);
            PG8_WAIT_V(6); PG8_BAR; PG8_MMA(1, 1, At, B1); PG8_BAR;
            PG8_LDB(B0, 1, 0); PG8_SCHED; PG8_LDA(At, 1, 0); PG8_STAGE(PG8_SA(0, 1), a2 + hstep, voffA);
            PG8_WAIT_L(8); PG8_BAR; PG8_WAIT_L(0); PG8_MMA(0, 0, At, B0); PG8_BAR; PG8_SCHED;
            PG8_LDB(B1, 1, 1); PG8_STAGE(PG8_SB(1, 0), b3, voffB);
            PG8_BAR; PG8_WAIT_L(0); PG8_MMA(0, 1, At, B1); PG8_BAR;
            PG8_LDA(At, 1, 1); PG8_STAGE(PG8_SA(1, 0), a3, voffA);
            PG8_BAR; PG8_WAIT_L(0); PG8_MMA(1, 0, At, B0); PG8_BAR; PG8_SCHED;
            PG8_STAGE(PG8_SB(1, 1), b3 + hstep, voffB);
            PG8_WAIT_V(6); PG8_BAR; PG8_MMA(1, 1, At, B1); PG8_BAR;
        }
        PG8_STAMP();
        if constexpr (!Epi::AFTER_DRAIN) { E(acc, cur, wr, wc, fr, fq); S.done(cur); }
        PG8_STAMP();
        if (!has_next) break;
#pragma unroll
        for (int a = 0; a < 2; ++a)
#pragma unroll
            for (int b = 0; b < 2; ++b)
#pragma unroll
                for (int m = 0; m < 4; ++m)
#pragma unroll
                    for (int n = 0; n < 2; ++n) acc[a][b][m][n] = (f32x4){0.f, 0.f, 0.f, 0.f};
        cur = nxt; cA = nA; cB = nB; ++ui;
    }
    PG8_WAIT_V(0);
    if (wr == 0) PG8_BAR;
    PG8_BAR;
    if constexpr (Epi::AFTER_DRAIN) { E.fused(acc, cur, wr, wc, fr, fq, lds, wid, lane); S.done(cur); }
    PG8_STAMP();
    if (STAMP && wid == 0) { stamps[lane] = lane < nts ? (((unsigned long long)(unsigned)ts_hi << 32) | (unsigned)ts_lo) : 0ull;
        if (lane == 62) stamps[62] = rt_entry; if (lane == 63) stamps[63] = (unsigned long long)wall_clock64(); }
#undef PG8_STAMP
#undef PG8_SA
#undef PG8_SB
#undef PG8_STAGE
#undef PG8_LDA
#undef PG8_LDB
#undef PG8_MMA
#undef PG8_WAIT_V
#undef PG8_WAIT_L
#undef PG8_BAR
#undef PG8_SCHED
}
}

using pg8::bf16_t; using pg8::bf16x8; using pg8::f32x4; using pg8::u32x4;
#define LAS __attribute__((address_space(3)))
typedef float f32x2 __attribute__((ext_vector_type(2)));
typedef unsigned u32x2 __attribute__((ext_vector_type(2)));

constexpr int DM = 1024, NBP = 8, TT = 2048, MP = NBP * TT, NS = 128, MT = MP + NS, DIN = 5136;
constexpr int C_XA = 0, C_ZA = 1024, C_Q = 2048, C_K = 2560, C_V = 3072, C_GLR = 4096, C_ZG = 4112;
constexpr float EPS = 1e-6f;
constexpr int LDS_BYTES = 139264;
constexpr size_t O_YP = 0, O_YS = 16777216, O_HP = O_YS + 131072, O_CP = O_HP + 8192, O_GP = O_CP + 24576, O_HS = O_GP + 1048576, O_CS = O_HS + 131072, O_GS = O_CS + 393216;
constexpr size_t O_SLOC = 8388608;
constexpr size_t al(size_t x) { return (x + 255) & ~(size_t)255; }
constexpr size_t W_ROWSS = 0;
constexpr size_t W_ADA = al(W_ROWSS + (size_t)MT * 4);
constexpr size_t W_WTIN = al(W_ADA + (size_t)136 * 3072 * 4);
constexpr size_t W_WTOUT = al(W_WTIN + (size_t)DIN * 1024 * 2);
constexpr size_t W_WTGX = al(W_WTOUT + (size_t)1024 * 2048 * 2);
constexpr size_t W_WTGA = al(W_WTGX + (size_t)8 * 128 * 128 * 2);
constexpr size_t W_HNS = al(W_WTGA + (size_t)8 * 128 * 128 * 2);
constexpr size_t W_GLRP = al(W_HNS + (size_t)128 * 1024 * 2);
constexpr size_t W_ZS = al(W_GLRP + (size_t)MP * 16 * 4);
constexpr size_t W_MIX = al(W_ZS + (size_t)NS * DIN * 4);
constexpr size_t W_SEGA = al(W_MIX + (size_t)MT * 2048 * 2);
constexpr size_t W_SEGH = al(W_SEGA + (size_t)8 * 32 * 1024 * 4);
constexpr size_t W_DSEG = al(W_SEGH + (size_t)8 * 32 * 1024 * 4);
constexpr size_t W_Z = al(W_DSEG + (size_t)8 * 4 * 8 * 128 * 4);
constexpr size_t W_END = W_Z + (size_t)MP * DIN * 2;

enum { I_XP = 0, I_XS, I_STH, I_STC, I_STG, I_CP, I_CS, I_GN, I_WADA, I_BADA, I_WIN, I_CW, I_CB, I_WGX, I_BGX, I_WGA, I_BGA, I_LAM, I_WG2, I_BG2, I_GGLA, I_WOUT, I_GFIN, N_IN };
struct Params { const float* in[N_IN]; float* out; unsigned char* ws; int ph_lo, ph_hi; };

__device__ __forceinline__ float bf2f(unsigned b) { return __uint_as_float(b << 16); }
__device__ __forceinline__ float bflo(unsigned u) { return __uint_as_float(u << 16); }
__device__ __forceinline__ float bfhi(unsigned u) { return __uint_as_float(u & 0xffff0000u); }
__device__ __forceinline__ unsigned pk2(float lo, float hi) { unsigned r; asm("v_cvt_pk_bf16_f32 %0, %1, %2" : "=v"(r) : "v"(lo), "v"(hi)); return r; }
__device__ __forceinline__ bf16_t f2bf(float x) { return (bf16_t)(pk2(x, 0.f) & 0xffffu); }
__device__ __forceinline__ float sigm(float x) { return 1.f / (1.f + __expf(-x)); }
__device__ __forceinline__ float silu(float x) { return x * sigm(x); }
__device__ __forceinline__ float logsig(float x) { return fminf(x, 0.f) - log1pf(__expf(-fabsf(x))); }
__device__ __forceinline__ float wave_sum(float v) {
#pragma unroll
    for (int o = 1; o < 64; o <<= 1) v += __shfl_xor(v, o);
    return v;
}
#define MFMA16(a, b, c) __builtin_amdgcn_mfma_f32_16x16x32_bf16((a), (b), (c), 0, 0, 0)

__device__ __forceinline__ void phase0(const Params& p, LAS unsigned char* lds) {
    const int tid = threadIdx.x, lane = tid & 63, wave = __builtin_amdgcn_readfirstlane(tid >> 6);
    { float* rowss = (float*)(p.ws + W_ROWSS); for (int i = blockIdx.x * 512 + tid; i < MT; i += gridDim.x * 512) rowss[i] = 0.f; }
    constexpr int I_IN = 16 * 161, I_OUT = 32 * 32, I_G = 128, TI = I_IN + I_OUT + I_G, NTB = (TI + 7) / 8, NADA = 48 * 8;
    for (int jb = blockIdx.x; jb < NTB + NADA; jb += gridDim.x) {
        if (jb < NTB) {
            const int it = jb * 8 + wave;
            LAS float* scr = (LAS float*)(lds + wave * 8448);
            const float* W = p.in[I_WIN]; bf16_t* WT = (bf16_t*)(p.ws + W_WTIN); int K = 1024, N = DIN, nblk = 161, item = it;
            if (it >= I_IN + I_OUT) {
                const int r = it - I_IN - I_OUT, g = r >> 6, nn = (r >> 3) & 7;
                W = (g ? p.in[I_WGA] : p.in[I_WGX]) + nn * 16384; WT = (bf16_t*)(p.ws + (g ? W_WTGA : W_WTGX)) + nn * 16384; K = 128; N = 128; nblk = 4; item = r & 7;
            } else if (it >= I_IN) { W = p.in[I_WOUT]; WT = (bf16_t*)(p.ws + W_WTOUT); K = 2048; N = 1024; nblk = 32; item = it - I_IN; }
            const bool valid = it < TI;
            const int kb = item / nblk, nb = item % nblk, k0 = 64 * kb, n0 = 32 * nb;
            if (valid) {
                const int n = n0 + (lane & 31);
#pragma unroll 8
                for (int i = 0; i < 32; ++i) { const int kk = 2 * i + (lane >> 5); scr[kk * 33 + (lane & 31)] = (n < N) ? W[(size_t)(k0 + kk) * N + n] : 0.f; }
            }
            __syncthreads();
            if (valid) {
                const int c = lane & 7;
#pragma unroll
                for (int j = 0; j < 4; ++j) { const int n = (lane >> 3) + 8 * j; const LAS float* s = scr + (8 * c) * 33 + n;
                    if (n0 + n < N) { u32x4 o; o.x = pk2(s[0], s[33]); o.y = pk2(s[66], s[99]); o.z = pk2(s[132], s[165]); o.w = pk2(s[198], s[231]);
                        *(u32x4*)(WT + (size_t)(n0 + n) * K + k0 + 8 * c) = o; } }
            }
            __syncthreads();
        } else {
            const int ai = jb - NTB, ct = ai % 48, rg = ai / 48;
            LAS float* sl = (LAS float*)lds;
            LAS float* red = (LAS float*)(lds + 17 * 1024 * 4);
            for (int i = tid; i < 17 * 1024; i += 512) { const int r = rg * 17 + (i >> 10), k = i & 1023;
                const float c = r < 8 ? p.in[I_CP][r * 1024 + k] : p.in[I_CS][(r - 8) * 1024 + k]; sl[i] = silu(c); }
            __syncthreads();
            const int col = tid & 63, kg = tid >> 6;
            float acc[17];
#pragma unroll
            for (int r = 0; r < 17; ++r) acc[r] = 0.f;
            const float* wp = p.in[I_WADA] + (size_t)(kg * 128) * 3072 + ct * 64 + col;
#pragma unroll 2
            for (int k4 = 0; k4 < 128; k4 += 4) {
                const float w0 = wp[(size_t)(k4 + 0) * 3072], w1 = wp[(size_t)(k4 + 1) * 3072], w2 = wp[(size_t)(k4 + 2) * 3072], w3 = wp[(size_t)(k4 + 3) * 3072];
#pragma unroll
                for (int r = 0; r < 17; ++r) { const f32x4 s = *(const LAS f32x4*)(sl + r * 1024 + kg * 128 + k4); acc[r] += s.x * w0 + s.y * w1 + s.z * w2 + s.w * w3; }
            }
#pragma unroll
            for (int r = 0; r < 17; ++r) red[(kg * 17 + r) * 64 + col] = acc[r];
            __syncthreads();
            float* ada = (float*)(p.ws + W_ADA);
            for (int o = tid; o < 17 * 64; o += 512) { const int r = o >> 6, c = o & 63; float s = p.in[I_BADA][ct * 64 + c];
#pragma unroll
                for (int g = 0; g < 8; ++g) s += red[(g * 17 + r) * 64 + c];
                ada[(size_t)(rg * 17 + r) * 3072 + ct * 64 + c] = s; }
            __syncthreads();
        }
    }
}

__device__ __forceinline__ void phase1(const Params& p) {
    const int tid = threadIdx.x, lane = tid & 63, wave = __builtin_amdgcn_readfirstlane(tid >> 6);
    const float* ada = (const float*)(p.ws + W_ADA);
    for (int row = blockIdx.x * 8 + wave; row < MT; row += gridDim.x * 8) {
        const bool pr = row < MP;
        const float* xr = pr ? p.in[I_XP] + (size_t)row * 1024 : p.in[I_XS] + (size_t)(row - MP) * 1024;
        const int ar = pr ? (row >> 11) : 8 + row - MP;
        bf16_t* hr = pr ? (bf16_t*)p.out + (size_t)row * 1024 : (bf16_t*)(p.ws + W_HNS) + (size_t)(row - MP) * 1024;
        f32x4 v[4]; float ss = 0.f;
#pragma unroll
        for (int j = 0; j < 4; ++j) { v[j] = *(const f32x4*)(xr + 4 * (lane + 64 * j)); ss += v[j].x * v[j].x + v[j].y * v[j].y + v[j].z * v[j].z + v[j].w * v[j].w; }
        ss = wave_sum(ss);
        const float rstd = 1.0f / sqrtf(ss * (1.f / 1024.f) + EPS);
#pragma unroll
        for (int j = 0; j < 4; ++j) { const int col = 4 * (lane + 64 * j);
            const f32x4 g = *(const f32x4*)(p.in[I_GN] + col), sh = *(const f32x4*)(ada + (size_t)ar * 3072 + col), sc = *(const f32x4*)(ada + (size_t)ar * 3072 + 1024 + col);
            const f32x4 hv = v[j] * rstd * g * (sc + 1.f) + sh;
            u32x2 o; o.x = pk2(hv.x, hv.y); o.y = pk2(hv.z, hv.w);
            *(u32x2*)(hr + col) = o; }
    }
}

__device__ __forceinline__ f32x4 skinny_tile(const bf16_t* A, int lda, const bf16_t* Bt, int ldb, int K, int lane) {
    const int fr = lane & 15, fq = lane >> 4;
    const bf16x8* pa = (const bf16x8*)(A + (size_t)fr * lda + fq * 8);
    const bf16x8* pb = (const bf16x8*)(Bt + (size_t)fr * ldb + fq * 8);
    f32x4 acc = {0.f, 0.f, 0.f, 0.f};
#pragma unroll 8
    for (int s = 0; s < K / 32; ++s) acc = MFMA16(pa[s * 4], pb[s * 4], acc);
    return acc;
}

struct EpiZ {
    static constexpr bool PERM = true, AFTER_DRAIN = false;
    bf16_t* Z;
    __device__ __forceinline__ void operator()(const f32x4 (&acc)[2][2][4][2], const pg8::Unit& u, int wr, int wc, int fr, int fq) const {
        const int row0 = u.pm * 256 + wr * 64 + fr, col0 = u.pn * 256 + (u.pn >= 16 ? 16 : 0) + wc * 32 + 8 * fq;
#pragma unroll
        for (int ai = 0; ai < 2; ++ai)
#pragma unroll
            for (int m = 0; m < 4; ++m) { bf16_t* rowp = Z + (size_t)(row0 + ai * 128 + m * 16) * DIN + col0;
#pragma unroll
                for (int bj = 0; bj < 2; ++bj) { const f32x4 v0 = acc[ai][bj][m][0], v1 = acc[ai][bj][m][1];
                    u32x4 o; o.x = pk2(v0[0], v0[1]); o.y = pk2(v0[2], v0[3]); o.z = pk2(v1[0], v1[1]); o.w = pk2(v1[2], v1[3]);
                    *(u32x4*)(rowp + bj * 128) = o; } }
    }
};
struct EpiY {
    static constexpr bool PERM = false, AFTER_DRAIN = false;
    const float* x; const float* ada; float* y; float* rowss;
    __device__ __forceinline__ void operator()(const f32x4 (&acc)[2][2][4][2], const pg8::Unit& u, int wr, int wc, int fr, int fq) const {
        const int row0 = u.pm * 256 + wr * 64 + fr, col0 = u.pn * 256 + wc * 32 + 4 * fq, bb = u.pm >> 3;
        f32x4 gv[2][2];
#pragma unroll
        for (int bj = 0; bj < 2; ++bj)
#pragma unroll
            for (int n = 0; n < 2; ++n) gv[bj][n] = *(const f32x4*)(ada + (size_t)bb * 3072 + 2048 + col0 + bj * 128 + n * 16);
#pragma unroll
        for (int ai = 0; ai < 2; ++ai)
#pragma unroll
            for (int m = 0; m < 4; ++m) { const int row = row0 + ai * 128 + m * 16; const float* xr = x + (size_t)row * 1024 + col0; float* yr = y + (size_t)row * 1024 + col0; float ss = 0.f;
#pragma unroll
                for (int bj = 0; bj < 2; ++bj)
#pragma unroll
                    for (int n = 0; n < 2; ++n) { const f32x4 xv = *(const f32x4*)(xr + bj * 128 + n * 16); const f32x4 v = xv + gv[bj][n] * acc[ai][bj][m][n];
                        *(f32x4*)(yr + bj * 128 + n * 16) = v; ss += v.x * v.x + v.y * v.y + v.z * v.z + v.w * v.w; }
                ss += __shfl_xor(ss, 16); ss += __shfl_xor(ss, 32);
                if (fq == 0) atomicAdd(rowss + row, ss); }
    }
};

__device__ __forceinline__ void phase2(const Params& p, LAS unsigned char* lds) {
    const int tid = threadIdx.x, lane = tid & 63, wave = __builtin_amdgcn_readfirstlane(tid >> 6), fr = lane & 15, fq = lane >> 4;
    const bf16_t* hnp = (const bf16_t*)p.out; const bf16_t* hns = (const bf16_t*)(p.ws + W_HNS); const bf16_t* wt = (const bf16_t*)(p.ws + W_WTIN);
    float* glrp = (float*)(p.ws + W_GLRP); float* zs = (float*)(p.ws + W_ZS);
    for (int i = blockIdx.x * 8 + wave; i < 1024 + 8 * 321; i += gridDim.x * 8) {
        if (i < 1024) { const f32x4 a = skinny_tile(hnp + (size_t)i * 16 * 1024, 1024, wt + (size_t)C_GLR * 1024, 1024, 1024, lane);
#pragma unroll
            for (int j = 0; j < 4; ++j) glrp[(size_t)(i * 16 + 4 * fq + j) * 16 + fr] = a[j];
        } else { const int r = i - 1024, rt = r / 321, ct = r % 321; const f32x4 a = skinny_tile(hns + (size_t)rt * 16 * 1024, 1024, wt + (size_t)ct * 16 * 1024, 1024, 1024, lane);
#pragma unroll
            for (int j = 0; j < 4; ++j) zs[(size_t)(rt * 16 + 4 * fq + j) * DIN + ct * 16 + fr] = a[j]; }
    }
    __syncthreads();
    pg8::Gemm g{hnp, wt, MP, 5120, 1024, 16, 16};
    pg8::StaticOrder S; S.init(MP, 5120, (int)gridDim.x, (int)blockIdx.x);
    EpiZ E{(bf16_t*)(p.ws + W_Z)};
    pg8::gemm_phase<EpiZ, pg8::StaticOrder, false>(lds, g, S, E, nullptr);
    __syncthreads();
}

template <int PASS>
__device__ __forceinline__ void lru_item(const Params& p, LAS unsigned char* lds, int b, int seg, int n) {
    const int tid = threadIdx.x, lane = tid & 63, wave = __builtin_amdgcn_readfirstlane(tid >> 6), fr = lane & 15, fq = lane >> 4;
    LAS unsigned char* XC = lds;
    LAS float* XCF = (LAS float*)(lds + 17408);
    LAS float* AA = (LAS float*)(lds + 17408 + 32768);
    LAS float* UU = (LAS float*)(lds + 17408 + 65536);
    LAS float* SP = (LAS float*)(lds + 17408 + 98304);
    LAS float* SH = SP + 512;
    const bf16_t* z = (const bf16_t*)(p.ws + W_Z);
    float* segA = (float*)(p.ws + W_SEGA); float* segH = (float*)(p.ws + W_SEGH);
    const int t0 = seg * 64; const size_t rowb = (size_t)b * TT;
    {
        const int ch = n * 128 + 2 * lane;
        const bf16_t* zb = z + rowb * DIN + C_XA + ch;
        f32x2 xv[11];
#pragma unroll
        for (int i = 0; i < 11; ++i) { const int t = t0 + wave * 8 - 3 + i; unsigned u = 0u; if (t >= 0) u = *(const unsigned*)(zb + (size_t)t * DIN); xv[i].x = bflo(u); xv[i].y = bfhi(u); }
        f32x2 cw[4];
#pragma unroll
        for (int j = 0; j < 4; ++j) cw[j] = *(const f32x2*)(p.in[I_CW] + j * 1024 + ch);
        const f32x2 cb = *(const f32x2*)(p.in[I_CB] + ch);
#pragma unroll
        for (int r = 0; r < 8; ++r) { const f32x2 xc = cb + cw[0] * xv[r] + cw[1] * xv[r + 1] + cw[2] * xv[r + 2] + cw[3] * xv[r + 3]; const int row = wave * 8 + r;
            *(LAS f32x2*)(XCF + row * 128 + 2 * lane) = xc; *(LAS unsigned*)(XC + row * 272 + lane * 4) = pk2(xc.x, xc.y); }
        if (PASS == 2 && seg == 31 && wave == 7) {
#pragma unroll
            for (int j = 0; j < 3; ++j) *(f32x2*)(p.out + O_CP + (size_t)b * 3072 + j * 1024 + ch) = xv[8 + j]; }
    }
    __syncthreads();
    f32x4 ax[4], aa[4];
#pragma unroll
    for (int rt = 0; rt < 4; ++rt) { ax[rt] = (f32x4){0.f, 0.f, 0.f, 0.f}; aa[rt] = (f32x4){0.f, 0.f, 0.f, 0.f}; }
    {
        const bf16_t* wx = (const bf16_t*)(p.ws + W_WTGX) + (size_t)(n * 128 + wave * 16 + fr) * 128 + fq * 8;
        const bf16_t* wa = (const bf16_t*)(p.ws + W_WTGA) + (size_t)(n * 128 + wave * 16 + fr) * 128 + fq * 8;
        bf16x8 bx[4], ba[4];
#pragma unroll
        for (int ks = 0; ks < 4; ++ks) { bx[ks] = *(const bf16x8*)(wx + ks * 32); ba[ks] = *(const bf16x8*)(wa + ks * 32); }
#pragma unroll
        for (int rt = 0; rt < 4; ++rt)
#pragma unroll
            for (int ks = 0; ks < 4; ++ks) { const bf16x8 a = *(const LAS bf16x8*)(XC + (rt * 16 + fr) * 272 + ks * 64 + fq * 16); ax[rt] = MFMA16(a, bx[ks], ax[rt]); aa[rt] = MFMA16(a, ba[ks], aa[rt]); }
    }
    {
        const int e = wave * 16 + fr, ch = n * 128 + e;
        const float bgx = p.in[I_BGX][ch], bga = p.in[I_BGA][ch], c8 = 8.f * logsig(p.in[I_LAM][ch]);
#pragma unroll
        for (int rt = 0; rt < 4; ++rt)
#pragma unroll
            for (int j = 0; j < 4; ++j) { const int row = rt * 16 + 4 * fq + j; const float gx = sigm(ax[rt][j] + bgx), ga = sigm(aa[rt][j] + bga), la = c8 * ga;
                AA[row * 128 + e] = __expf(la); UU[row * 128 + e] = sqrtf(-expm1f(2.f * la)) * gx * XCF[row * 128 + e]; }
    }
    __syncthreads();
    {
        const int e = tid & 127, sg = tid >> 7, ch = n * 128 + e;
        float P = 1.f, H = 0.f;
#pragma unroll
        for (int r = 0; r < 16; ++r) { const float a = AA[(sg * 16 + r) * 128 + e], u = UU[(sg * 16 + r) * 128 + e]; H = a * H + u; P *= a; }
        SP[sg * 128 + e] = P; SH[sg * 128 + e] = H;
        __syncthreads();
        if (PASS == 1) {
            if (sg == 0) { float Pt = 1.f, Ht = 0.f;
#pragma unroll
                for (int s = 0; s < 4; ++s) { Ht = SP[s * 128 + e] * Ht + SH[s * 128 + e]; Pt *= SP[s * 128 + e]; }
                segA[(size_t)(b * 32 + seg) * 1024 + ch] = Pt; segH[(size_t)(b * 32 + seg) * 1024 + ch] = Ht; }
        } else {
            float hc = 0.f;
            for (int s = 0; s < seg; ++s) hc = segA[(size_t)(b * 32 + s) * 1024 + ch] * hc + segH[(size_t)(b * 32 + s) * 1024 + ch];
            for (int s = 0; s < sg; ++s) hc = SP[s * 128 + e] * hc + SH[s * 128 + e];
            bf16_t* mix = (bf16_t*)(p.ws + W_MIX);
#pragma unroll
            for (int r = 0; r < 16; ++r) { const int row = sg * 16 + r; const size_t gr = rowb + t0 + row;
                hc = AA[row * 128 + e] * hc + UU[row * 128 + e];
                const float za = bf2f(z[gr * DIN + C_ZA + ch]);
                mix[gr * 2048 + ch] = f2bf(hc * silu(za)); }
            if (seg == 31 && sg == 3) p.out[O_HP + (size_t)b * 1024 + ch] = hc;
        }
    }
    __syncthreads();
}

template <int PASS>
__device__ __forceinline__ void gla_item(const Params& p, LAS unsigned char* lds, int b, int h, int seg) {
    const int tid0 = threadIdx.x, lane = tid0 & 63, wave = __builtin_amdgcn_readfirstlane(tid0 >> 6), fr0 = lane & 15, fq0 = lane >> 4;
    int tid = tid0, fr = fr0, fq = fq0;
    LAS unsigned char* QI = lds;
    LAS unsigned char* KI = lds + 8704;
    LAS unsigned char* KDT = lds + 17408;
    LAS unsigned char* VT = lds + 27648;
    LAS unsigned char* AM = lds + 48128;
    LAS unsigned char* ST = lds + 50688;
    LAS float* GLR = (LAS float*)(lds + 120320);
    LAS float* PT = (LAS float*)(lds + 122368);
    LAS float* DEC = (LAS float*)(lds + 126464);
    LAS float* RSS = (LAS float*)(lds + 126976);
    const bf16_t* z = (const bf16_t*)(p.ws + W_Z);
    const float* glrp = (const float*)(p.ws + W_GLRP);
    float* Sloc = p.out + O_SLOC; float* Dseg = (float*)(p.ws + W_DSEG);
    bf16_t* mix = (bf16_t*)(p.ws + W_MIX);
    const int bh = b * 4 + h; int kk0 = 2 * lane;
    LAS float* WG = (LAS float*)(lds + 127488);
    for (int i = tid; i < 2048; i += 512) WG[i] = p.in[I_WG2][(i >> 7) * 512 + h * 128 + (i & 127)];
    const f32x2 bg = *(const f32x2*)(p.in[I_BG2] + h * 128 + kk0);
    f32x4 S[2][8];
#pragma unroll
    for (int a = 0; a < 2; ++a)
#pragma unroll
        for (int k = 0; k < 8; ++k) S[a][k] = (f32x4){0.f, 0.f, 0.f, 0.f};
    f32x2 ltot = {0.f, 0.f};
    if (PASS == 2) {
        for (int s = 0; s < seg; ++s) {
            const float* Sl = Sloc + (size_t)(bh * 8 + s) * 32768; const float* Dv = Dseg + (size_t)(bh * 8 + s) * 128;
#pragma unroll
            for (int kt = 0; kt < 8; ++kt) { const f32x4 d = *(const f32x4*)(Dv + 16 * kt + 4 * fq);
#pragma unroll
                for (int a = 0; a < 2; ++a) S[a][kt] = d * S[a][kt] + *(const f32x4*)(Sl + (size_t)((a * 8 + kt) * 512 + tid) * 4); }
        }
#pragma unroll
        for (int a = 0; a < 2; ++a)
#pragma unroll
            for (int kt = 0; kt < 8; ++kt) { u32x2 o; o.x = pk2(S[a][kt][0], S[a][kt][1]); o.y = pk2(S[a][kt][2], S[a][kt][3]);
                *(LAS u32x2*)(ST + (16 * (2 * wave + a) + fr) * 272 + (16 * kt + 4 * fq) * 2) = o; }
    }
    for (int c = 0; c < 8; ++c) {
        tid = tid0; fr = fr0; fq = fq0; kk0 = 2 * lane;
        asm volatile("" : "+v"(tid), "+v"(fr), "+v"(fq), "+v"(kk0));
        const size_t row0 = (size_t)b * TT + seg * 256 + c * 32;
        GLR[tid] = glrp[row0 * 16 + tid];
        unsigned qv[4], kv[4], vraw[2][4];
#pragma unroll
        for (int r = 0; r < 4; ++r) { const bf16_t* zr = z + (row0 + 4 * wave + r) * DIN + h * 128 + kk0; kv[r] = *(const unsigned*)(zr + C_K); qv[r] = (PASS == 2) ? *(const unsigned*)(zr + C_Q) : 0u; }
#pragma unroll
        for (int i = 0; i < 2; ++i) { const int idx = tid + i * 512, vp = idx & 127, tg = idx >> 7;
#pragma unroll
            for (int r = 0; r < 4; ++r) vraw[i][r] = *(const unsigned*)(z + (row0 + 4 * tg + r) * DIN + C_V + h * 256 + 2 * vp); }
        __syncthreads();
        f32x2 cs[4];
        {
            f32x2 run = {0.f, 0.f};
#pragma unroll
            for (int r = 0; r < 4; ++r) { f32x2 x = bg;
#pragma unroll
                for (int q4 = 0; q4 < 4; ++q4) { const f32x4 g = *(const LAS f32x4*)(GLR + (4 * wave + r) * 16 + 4 * q4);
                    x += g.x * *(const LAS f32x2*)(WG + (4 * q4) * 128 + kk0) + g.y * *(const LAS f32x2*)(WG + (4 * q4 + 1) * 128 + kk0)
                       + g.z * *(const LAS f32x2*)(WG + (4 * q4 + 2) * 128 + kk0) + g.w * *(const LAS f32x2*)(WG + (4 * q4 + 3) * 128 + kk0); }
                run.x += logsig(x.x) * 0.0625f; run.y += logsig(x.y) * 0.0625f; cs[r] = run; }
            *(LAS f32x2*)(PT + wave * 128 + kk0) = run;
        }
        __syncthreads();
        f32x2 off = {0.f, 0.f}, tot = {0.f, 0.f};
#pragma unroll
        for (int w = 0; w < 8; ++w) { const f32x2 t = *(const LAS f32x2*)(PT + w * 128 + kk0); tot += t; if (w < wave) off += t; }
        ltot += tot;
        if (wave == 0) { f32x2 d; d.x = __expf(tot.x); d.y = __expf(tot.y); *(LAS f32x2*)(DEC + kk0) = d; }
        {
            float kdx[4], kdy[4];
#pragma unroll
            for (int r = 0; r < 4; ++r) { const f32x2 bb = off + cs[r]; const float k0 = bflo(kv[r]), k1 = bfhi(kv[r]);
                kdx[r] = k0 * __expf(tot.x - bb.x); kdy[r] = k1 * __expf(tot.y - bb.y);
                if (PASS == 2) { const float q0 = bflo(qv[r]) * 0.08838834764831845f, q1 = bfhi(qv[r]) * 0.08838834764831845f;
                    *(LAS unsigned*)(QI + (4 * wave + r) * 272 + kk0 * 2) = pk2(q0 * __expf(bb.x), q1 * __expf(bb.y));
                    *(LAS unsigned*)(KI + (4 * wave + r) * 272 + kk0 * 2) = pk2(k0 * __expf(-bb.x), k1 * __expf(-bb.y)); } }
            u32x2 o; o.x = pk2(kdx[0], kdx[1]); o.y = pk2(kdx[2], kdx[3]); *(LAS u32x2*)(KDT + kk0 * 80 + wave * 8) = o;
            o.x = pk2(kdy[0], kdy[1]); o.y = pk2(kdy[2], kdy[3]); *(LAS u32x2*)(KDT + (kk0 + 1) * 80 + wave * 8) = o;
        }
#pragma unroll
        for (int i = 0; i < 2; ++i) { const int idx = tid + i * 512, vp = idx & 127, tg = idx >> 7;
            u32x2 lo, hi;
            lo.x = (vraw[i][0] & 0xffffu) | (vraw[i][1] << 16); lo.y = (vraw[i][2] & 0xffffu) | (vraw[i][3] << 16);
            hi.x = (vraw[i][0] >> 16) | (vraw[i][1] & 0xffff0000u); hi.y = (vraw[i][2] >> 16) | (vraw[i][3] & 0xffff0000u);
            *(LAS u32x2*)(VT + (2 * vp) * 80 + tg * 8) = lo; *(LAS u32x2*)(VT + (2 * vp + 1) * 80 + tg * 8) = hi; }
        __syncthreads();
        const int ct = wave >> 2;
        f32x4 o4[4];
        if (PASS == 2) {
            if (wave < 4) {
                const int st = wave >> 1, cti = wave & 1;
                f32x4 am = {0.f, 0.f, 0.f, 0.f};
#pragma unroll
                for (int ks = 0; ks < 4; ++ks) { const bf16x8 ka = *(const LAS bf16x8*)(KI + (16 * st + fr) * 272 + ks * 64 + fq * 16), qb = *(const LAS bf16x8*)(QI + (16 * cti + fr) * 272 + ks * 64 + fq * 16);
                    am = MFMA16(ka, qb, am); }
                const int cc = 16 * cti + fr; float m[4];
#pragma unroll
                for (int j = 0; j < 4; ++j) m[j] = (16 * st + 4 * fq + j <= cc) ? am[j] : 0.f;
                u32x2 o; o.x = pk2(m[0], m[1]); o.y = pk2(m[2], m[3]);
                *(LAS u32x2*)(AM + cc * 80 + (16 * st + 4 * fq) * 2) = o;
            }
            __syncthreads();
            const bf16x8 amf = *(const LAS bf16x8*)(AM + (16 * ct + fr) * 80 + fq * 16);
            float ss = 0.f;
#pragma unroll
            for (int i = 0; i < 4; ++i) { const int vt = 4 * (wave & 3) + i;
                const bf16x8 vf = *(const LAS bf16x8*)(VT + (16 * vt + fr) * 80 + fq * 16); o4[i] = MFMA16(vf, amf, ((f32x4){0.f, 0.f, 0.f, 0.f})); }
#pragma unroll
            for (int ks = 0; ks < 4; ++ks) { const bf16x8 qf = *(const LAS bf16x8*)(QI + (16 * ct + fr) * 272 + ks * 64 + fq * 16);
#pragma unroll
                for (int i = 0; i < 4; ++i) { const int vt = 4 * (wave & 3) + i; const bf16x8 sf = *(const LAS bf16x8*)(ST + (16 * vt + fr) * 272 + ks * 64 + fq * 16); o4[i] = MFMA16(sf, qf, o4[i]); } }
#pragma unroll
            for (int i = 0; i < 4; ++i) ss += o4[i].x * o4[i].x + o4[i].y * o4[i].y + o4[i].z * o4[i].z + o4[i].w * o4[i].w;
            ss += __shfl_xor(ss, 16); ss += __shfl_xor(ss, 32);
            if (fq == 0) RSS[(16 * ct + fr) * 4 + (wave & 3)] = ss;
            __syncthreads();
            const int cc = 16 * ct + fr; const f32x4 r4 = *(const LAS f32x4*)(RSS + cc * 4);
            const float rstd = 1.0f / sqrtf((r4.x + r4.y + r4.z + r4.w) * (1.f / 256.f) + EPS);
            const size_t row = row0 + cc;
#pragma unroll
            for (int i = 0; i < 4; ++i) { const int col = h * 256 + 16 * (4 * (wave & 3) + i) + 4 * fq;
                const f32x4 g = *(const f32x4*)(p.in[I_GGLA] + col); const u32x2 zg = *(const u32x2*)(z + row * DIN + C_ZG + col);
                u32x2 o; o.x = pk2(o4[i].x * rstd * g.x * silu(bflo(zg.x)), o4[i].y * rstd * g.y * silu(bfhi(zg.x)));
                o.y = pk2(o4[i].z * rstd * g.z * silu(bflo(zg.y)), o4[i].w * rstd * g.w * silu(bfhi(zg.y)));
                *(u32x2*)(mix + row * 2048 + 1024 + col) = o; }
        }
        {
            bf16x8 vf[2];
#pragma unroll
            for (int a = 0; a < 2; ++a) vf[a] = *(const LAS bf16x8*)(VT + (16 * (2 * wave + a) + fr) * 80 + fq * 16);
#pragma unroll
            for (int kt = 0; kt < 8; ++kt) { const f32x4 d = *(const LAS f32x4*)(DEC + 16 * kt + 4 * fq); const bf16x8 kf = *(const LAS bf16x8*)(KDT + (16 * kt + fr) * 80 + fq * 16);
#pragma unroll
                for (int a = 0; a < 2; ++a) S[a][kt] = MFMA16(kf, vf[a], S[a][kt] * d); }
        }
        if (PASS == 2) {
#pragma unroll
            for (int a = 0; a < 2; ++a)
#pragma unroll
                for (int kt = 0; kt < 8; ++kt) { u32x2 o; o.x = pk2(S[a][kt][0], S[a][kt][1]); o.y = pk2(S[a][kt][2], S[a][kt][3]);
                    *(LAS u32x2*)(ST + (16 * (2 * wave + a) + fr) * 272 + (16 * kt + 4 * fq) * 2) = o; }
        }
        __syncthreads();
    }
    if (PASS == 1) {
        float* Sl = Sloc + (size_t)(bh * 8 + seg) * 32768;
#pragma unroll
        for (int a = 0; a < 2; ++a)
#pragma unroll
            for (int kt = 0; kt < 8; ++kt) *(f32x4*)(Sl + (size_t)((a * 8 + kt) * 512 + tid) * 4) = S[a][kt];
        if (wave == 0) { f32x2 d; d.x = __expf(ltot.x); d.y = __expf(ltot.y); *(f32x2*)(Dseg + (size_t)(bh * 8 + seg) * 128 + kk0) = d; }
    } else if (seg == 7) {
        float* gb = p.out + O_GP + (size_t)bh * 32768 + (size_t)(4 * fq) * 256 + 32 * wave + fr;
#pragma unroll
        for (int kt = 0; kt < 8; ++kt)
#pragma unroll
            for (int j = 0; j < 4; ++j)
#pragma unroll
                for (int a = 0; a < 2; ++a) gb[(16 * kt + j) * 256 + 16 * a] = S[a][kt][j];
    }
}

__device__ __forceinline__ void gla_sample_item(const Params& p, LAS unsigned char* lds, int b, int h) {
    const int tid = threadIdx.x, lane = tid & 63, wave = __builtin_amdgcn_readfirstlane(tid >> 6);
    LAS float* AL = (LAS float*)lds; LAS float* KK = AL + 128; LAS float* QQ = AL + 256; LAS float* OS = AL + 384; LAS float* RS = OS + 2048;
    const float* zs = (const float*)(p.ws + W_ZS) + (size_t)b * DIN;
    if (tid < 128) { const int kk = tid; float x = p.in[I_BG2][h * 128 + kk];
#pragma unroll
        for (int r = 0; r < 16; ++r) x += zs[C_GLR + r] * p.in[I_WG2][r * 512 + h * 128 + kk];
        AL[kk] = __expf(logsig(x) * 0.0625f); KK[kk] = zs[C_K + h * 128 + kk]; QQ[kk] = zs[C_Q + h * 128 + kk] * 0.08838834764831845f; }
    __syncthreads();
    const f32x4 vv = *(const f32x4*)(zs + C_V + h * 256 + 4 * lane);
    const float* S0 = p.in[I_STG] + (size_t)(b * 4 + h) * 32768; float* Sn = p.out + O_GS + (size_t)(b * 4 + h) * 32768;
    f32x4 o = {0.f, 0.f, 0.f, 0.f};
#pragma unroll 8
    for (int i = 0; i < 16; ++i) { const int kk = wave * 16 + i; const f32x4 s = *(const f32x4*)(S0 + kk * 256 + 4 * lane); const f32x4 sn = s * AL[kk] + vv * KK[kk];
        *(f32x4*)(Sn + kk * 256 + 4 * lane) = sn; o += sn * QQ[kk]; }
    *(LAS f32x4*)(OS + wave * 256 + 4 * lane) = o;
    __syncthreads();
    float ov = 0.f;
    if (tid < 256) {
#pragma unroll
        for (int g = 0; g < 8; ++g) ov += OS[g * 256 + tid];
        const float ss = wave_sum(ov * ov); if (lane == 0) RS[wave] = ss; }
    __syncthreads();
    if (tid < 256) { const float rstd = 1.0f / sqrtf((RS[0] + RS[1] + RS[2] + RS[3]) * (1.f / 256.f) + EPS);
        const float y = ov * rstd * p.in[I_GGLA][h * 256 + tid] * silu(zs[C_ZG + h * 256 + tid]);
        ((bf16_t*)(p.ws + W_MIX))[(size_t)(MP + b) * 2048 + 1024 + h * 256 + tid] = f2bf(y); }
    __syncthreads();
}
__device__ __forceinline__ void lru_sample_item(const Params& p, LAS unsigned char* lds, int n, int rg) {
    const int tid = threadIdx.x;
    LAS float* XS = (LAS float*)lds;
    LAS float* RED = XS + 512;
    const float* zsb = (const float*)(p.ws + W_ZS);
    {
        const int r = tid >> 7, d = tid & 127, b = rg * 4 + r, ch = n * 128 + d;
        const float xa = zsb[(size_t)b * DIN + C_XA + ch];
        const float* cv = p.in[I_STC] + (size_t)b * 3072 + ch; const float c0 = cv[0], c1 = cv[1024], c2 = cv[2048];
        const float* cw = p.in[I_CW] + ch;
        XS[r * 128 + d] = p.in[I_CB][ch] + cw[0] * c0 + cw[1024] * c1 + cw[2048] * c2 + cw[3072] * xa;
        float* oc = p.out + O_CS + (size_t)b * 3072 + ch; oc[0] = c1; oc[1024] = c2; oc[2048] = xa;
    }
    __syncthreads();
    {
        const int e = tid & 127, q = tid >> 7;
        float gx[4] = {0.f, 0.f, 0.f, 0.f}, ga[4] = {0.f, 0.f, 0.f, 0.f};
        const float* wx = p.in[I_WGX] + (size_t)n * 16384 + (size_t)(q * 32) * 128 + e; const float* wa = p.in[I_WGA] + (size_t)n * 16384 + (size_t)(q * 32) * 128 + e;
#pragma unroll 8
        for (int d = 0; d < 32; ++d) { const float a = wx[d * 128], c = wa[d * 128];
#pragma unroll
            for (int r = 0; r < 4; ++r) { const float x = XS[r * 128 + q * 32 + d]; gx[r] += x * a; ga[r] += x * c; } }
#pragma unroll
        for (int r = 0; r < 4; ++r) { RED[((q * 2 + 0) * 4 + r) * 128 + e] = gx[r]; RED[((q * 2 + 1) * 4 + r) * 128 + e] = ga[r]; }
    }
    __syncthreads();
    {
        const int r = tid >> 7, e = tid & 127, b = rg * 4 + r, ch = n * 128 + e;
        float sx = p.in[I_BGX][ch], sa = p.in[I_BGA][ch];
#pragma unroll
        for (int q = 0; q < 4; ++q) { sx += RED[((q * 2 + 0) * 4 + r) * 128 + e]; sa += RED[((q * 2 + 1) * 4 + r) * 128 + e]; }
        const float gxv = sigm(sx), gav = sigm(sa), la = 8.f * gav * logsig(p.in[I_LAM][ch]);
        const float hn = __expf(la) * p.in[I_STH][(size_t)b * 1024 + ch] + sqrtf(-expm1f(2.f * la)) * gxv * XS[r * 128 + e];
        p.out[O_HS + (size_t)b * 1024 + ch] = hn;
        ((bf16_t*)(p.ws + W_MIX))[(size_t)(MP + b) * 2048 + ch] = f2bf(hn * silu(zsb[(size_t)b * DIN + C_ZA + ch]));
    }
    __syncthreads();
}

__global__ void __launch_bounds__(512, 2) fwd_kernel(Params p) {
    extern __shared__ __attribute__((aligned(16))) unsigned char shm[];
    LAS unsigned char* lds = (LAS unsigned char*)shm;
    cg::grid_group grid = cg::this_grid();
    const int G = (int)gridDim.x, bid = (int)blockIdx.x, tid = threadIdx.x, lane = tid & 63, wave = __builtin_amdgcn_readfirstlane(tid >> 6);
#ifndef SKIPMASK
#define SKIPMASK 0
#endif
#define PH(k) if (!((SKIPMASK >> (k)) & 1) && p.ph_lo <= (k) && (k) < p.ph_hi)
#define SEAM(k) if (p.ph_lo < (k)) grid.sync()
    PH(0) { phase0(p, lds); }
    PH(1) { SEAM(1); phase1(p); }
    PH(2) { SEAM(2); phase2(p, lds); }
    PH(3) { SEAM(3);
        for (int i = bid; i < 224; i += G) gla_item<1>(p, lds, (i / 7) >> 2, (i / 7) & 3, i % 7);
        __syncthreads();
        for (int i = bid; i < 512; i += G) gla_sample_item(p, lds, i >> 2, i & 3);
        for (int i = bid; i < 256; i += G) lru_sample_item(p, lds, i & 7, i >> 3);
        for (int i = bid; i < 2048; i += G) lru_item<1>(p, lds, i >> 8, (i >> 3) & 31, i & 7);
    }
    PH(4) { SEAM(4);
        for (int i = bid; i < 256; i += G) gla_item<2>(p, lds, i >> 5, (i >> 3) & 3, i & 7);
        __syncthreads();
        for (int i = bid; i < 2048; i += G) lru_item<2>(p, lds, i >> 8, (i >> 3) & 31, i & 7);
    }
    PH(5) { SEAM(5);
        {
            const int fr = lane & 15, fq = lane >> 4;
            const bf16_t* mixs = (const bf16_t*)(p.ws + W_MIX) + (size_t)MP * 2048; const bf16_t* wo = (const bf16_t*)(p.ws + W_WTOUT);
            const float* ada = (const float*)(p.ws + W_ADA); float* rowss = (float*)(p.ws + W_ROWSS);
            for (int i = bid * 8 + wave; i < 512; i += G * 8) { const int rt = i >> 6, ct = i & 63;
                const f32x4 a = skinny_tile(mixs + (size_t)rt * 16 * 2048, 2048, wo + (size_t)ct * 16 * 2048, 2048, 2048, lane);
#pragma unroll
                for (int j = 0; j < 4; ++j) { const int r = rt * 16 + 4 * fq + j, c = ct * 16 + fr;
                    const float v = p.in[I_XS][(size_t)r * 1024 + c] + ada[(size_t)(8 + r) * 3072 + 2048 + c] * a[j];
                    p.out[O_YS + (size_t)r * 1024 + c] = v;
                    float ss = v * v; ss += __shfl_xor(ss, 1); ss += __shfl_xor(ss, 2); ss += __shfl_xor(ss, 4); ss += __shfl_xor(ss, 8);
                    if (fr == 0) atomicAdd(rowss + MP + r, ss); }
            }
        }
        __syncthreads();
        pg8::Gemm g{(const bf16_t*)(p.ws + W_MIX), (const bf16_t*)(p.ws + W_WTOUT), MP, 1024, 2048, 1 << 30, 0};
        pg8::StaticOrder S; S.init(MP, 1024, G, bid);
        EpiY E{p.in[I_XP], (const float*)(p.ws + W_ADA), p.out + O_YP, (float*)(p.ws + W_ROWSS)};
        pg8::gemm_phase<EpiY, pg8::StaticOrder, false>(lds, g, S, E, nullptr);
    }
    PH(6) { SEAM(6);
        const float* rowss = (const float*)(p.ws + W_ROWSS);
        for (int row = bid * 8 + wave; row < MT; row += G * 8) { float* yr = p.out + (size_t)row * 1024;
            const float rstd = 1.0f / sqrtf(rowss[row] * (1.f / 1024.f) + EPS);
#pragma unroll
            for (int j = 0; j < 4; ++j) { const int col = 4 * (lane + 64 * j); const f32x4 v = *(const f32x4*)(yr + col), g = *(const f32x4*)(p.in[I_GFIN] + col); *(f32x4*)(yr + col) = v * rstd * g; }
        }
    }
}

#ifndef N_LAUNCH
#define N_LAUNCH 1
#endif
extern "C" void kernel_launch(void* const* d_in, const int* in_sizes, int n_in, void* d_out, int out_size, void* d_ws, size_t ws_size, hipStream_t stream) {
    static int grid = 0;
    if (grid == 0) {
        int dev = 0, cus = 0, per_cu = 0;
        if (n_in != N_IN || ws_size < W_END) { fprintf(stderr, "kernel_launch: unexpected problem: n_in %d ws %zu (need %zu)\n", n_in, ws_size, (size_t)W_END); grid = -1; return; }
        hipGetDevice(&dev); hipDeviceGetAttribute(&cus, hipDeviceAttributeMultiprocessorCount, dev);
        if (hipFuncSetAttribute((const void*)fwd_kernel, hipFuncAttributeMaxDynamicSharedMemorySize, LDS_BYTES) != hipSuccess) { fprintf(stderr, "kernel_launch: hipFuncSetAttribute failed\n"); grid = -1; return; }
        if (hipOccupancyMaxActiveBlocksPerMultiprocessor(&per_cu, (const void*)fwd_kernel, 512, LDS_BYTES) != hipSuccess || per_cu < 1) { fprintf(stderr, "kernel_launch: occupancy query says %d blocks per CU\n", per_cu); (void)hipGetLastError(); grid = -1; return; }
        grid = cus;
    }
    if (grid < 0) return;
    Params p; memset(&p, 0, sizeof(p));
    for (int i = 0; i < N_IN; ++i) p.in[i] = (const float*)d_in[i];
    p.out = (float*)d_out; p.ws = (unsigned char*)d_ws;
#if N_LAUNCH == 1
    p.ph_lo = 0; p.ph_hi = 7;
    void* args[] = {&p};
    hipError_t e = hipLaunchCooperativeKernel((const void*)fwd_kernel, dim3(grid), dim3(512), args, LDS_BYTES, stream);
    if (e != hipSuccess) fprintf(stderr, "kernel_launch: cooperative launch failed: %s (grid %d)\n", hipGetErrorString(e), grid);
#else
    for (int ph = 0; ph < 7; ++ph) { p.ph_lo = ph; p.ph_hi = ph + 1; hipLaunchKernelGGL(fwd_kernel, dim3(grid), dim3(512), LDS_BYTES, stream, p); }
#endif
}
```

```cpp
#include <hip/hip_runtime.h>
#include <hip/hip_cooperative_groups.h>
#include <cstdio>
#include <cstdint>
#include <cstring>
namespace cg = cooperative_groups;

namespace pg8 {
#define PG8_LAS __attribute__((address_space(3)))
typedef unsigned short bf16_t;
typedef short bf16x8 __attribute__((ext_vector_type(8)));
typedef float f32x4 __attribute__((ext_vector_type(4)));
typedef unsigned u32x4 __attribute__((ext_vector_type(4)));
constexpr int BM = 256, BK = 64, HALF = 128, HTB = HALF * BK * 2  , STAGE_BYTES = 8 * HTB, NXCD = 8, WGM = 8;

__host__ __device__ __forceinline__ int lds_byte(int r, int c) { const int st = (r >> 4) * 2 + (c >> 5), rr = r & 15, cc = c & 31, ob = rr * 64 + cc * 2; return st * 1024 + (ob ^ (((ob >> 9) & 1) << 5)); }
__host__ __device__ __forceinline__ void stage_rc(int b, int& R, int& C) { const int st = b / 1024, sb = b % 1024, swz = sb ^ (((sb >> 9) & 1) << 5); R = (st >> 1) * 16 + swz / 64; C = (st & 1) * 32 + (swz % 64) / 2; }
__host__ __device__ __forceinline__ int perm32(int rho) { const int n = rho >> 4, i = rho & 15; return 8 * (i >> 2) + 4 * n + (i & 3); }

struct Unit { int pm, pn; };
struct Gemm { const bf16_t* A; const bf16_t* Bt; int M, N, K; int skip_pn, skip_rows; };

struct StaticOrder {
    int nM, nN, nwg, G, c;
    __host__ __device__ void init(int M, int N, int G_, int c_) { nM = M / BM; nN = N / BM; nwg = nM * nN; G = G_; c = c_; }
    __host__ __device__ bool next(int i, Unit& u) const {
        const long L = (long)i * G + c; if (L >= nwg) return false;
        int wgid = (int)L; { const int q = nwg / NXCD, r = nwg % NXCD, xcd = wgid % NXCD, off = wgid / NXCD; wgid = (xcd < r ? xcd * (q + 1) : r * (q + 1) + (xcd - r) * q) + off; }
        const int nig = WGM * nN, gid = wgid / nig, fm = gid * WGM, gsz = (nM - fm) < WGM ? (nM - fm) : WGM;
        u.pm = fm + ((wgid % nig) % gsz); u.pn = (wgid % nig) / gsz; return true;
    }
    __device__ __forceinline__ void a_ready(const Unit&) const {}
    __device__ __forceinline__ void done(const Unit&) const {}
};
__device__ __forceinline__ unsigned cvt_pk_bf16(float lo, float hi) { unsigned r; asm volatile("v_cvt_pk_bf16_f32 %0, %1, %2" : "=v"(r) : "v"(lo), "v"(hi)); return r; }
template <class Epi, class Sched, bool STAMP = false>
__device__ __forceinline__ void gemm_phase(PG8_LAS unsigned char* lds, const Gemm g, const Sched& S, const Epi& E, unsigned long long* stamps) {
    const int tid = threadIdx.x, wid = __builtin_amdgcn_readfirstlane(tid >> 6), lane = tid & 63, wr = wid >> 2, wc = wid & 3, fr = lane & 15, fq = lane >> 4;
    const int K = g.K, nt = K / BK;
    int ts_lo = 0, ts_hi = 0, nts = 0; const unsigned long long rt_entry = STAMP ? (unsigned long long)wall_clock64() : 0ull;
#define PG8_STAMP() do { if (STAMP && wid == 0 && nts < 64) { const unsigned long long _c = (unsigned long long)clock64(); \
        ts_lo = (lane == nts) ? (int)(unsigned)_c : ts_lo; ts_hi = (lane == nts) ? (int)(unsigned)(_c >> 32) : ts_hi; ++nts; } } while (0)
    PG8_STAMP();
    unsigned voffA[2], voffB[2];
#pragma unroll
    for (int i = 0; i < 2; ++i) { int R, C; stage_rc(tid * 16 + i * 8192, R, C); const int Rb = Epi::PERM ? ((R & ~31) + perm32(R & 31)) : R;
        voffA[i] = (unsigned)(R * K + C) * 2u; voffB[i] = (unsigned)(Rb * K + C) * 2u; }
    const size_t kstep = (size_t)(BK * 2);
    const size_t hstep = (size_t)HALF * K * 2;
    const size_t tstep = 2 * hstep;
    const unsigned ldsw = (unsigned)wid * 1024u;
    const int aoff = lds_byte(wr * 64 + fr, fq * 8), boff = lds_byte(wc * 32 + fr, fq * 8);
#define PG8_SA(b, h) (((b) * 2 + (h)) * HTB)
#define PG8_SB(b, h) ((4 + (b) * 2 + (h)) * HTB)
#define PG8_STAGE(bufoff, gbase, voff) do { _Pragma("unroll") for (int _i = 0; _i < 2; ++_i) \
        __builtin_amdgcn_global_load_lds((const unsigned*)((const char*)(gbase) + (voff)[_i]), (PG8_LAS unsigned*)(lds + (bufoff) + ldsw + _i * 8192), 16, 0, 0); } while (0)
#define PG8_LDA(dst, b, h) do { _Pragma("unroll") for (int m = 0; m < 4; ++m) _Pragma("unroll") for (int k = 0; k < 2; ++k) dst[m][k] = *(const PG8_LAS bf16x8*)(lds + PG8_SA(b, h) + aoff + m * 2048 + k * 1024); } while (0)
#define PG8_LDB(dst, b, h) do { _Pragma("unroll") for (int n = 0; n < 2; ++n) _Pragma("unroll") for (int k = 0; k < 2; ++k) dst[n][k] = *(const PG8_LAS bf16x8*)(lds + PG8_SB(b, h) + boff + n * 2048 + k * 1024); } while (0)
#define PG8_MMA(ai, bj, At, Bt) do { __builtin_amdgcn_s_setprio(1); _Pragma("unroll") for (int m = 0; m < 4; ++m) _Pragma("unroll") for (int n = 0; n < 2; ++n) _Pragma("unroll") for (int k = 0; k < 2; ++k) \
        acc[ai][bj][m][n] = __builtin_amdgcn_mfma_f32_16x16x32_bf16(Bt[n][k], At[m][k], acc[ai][bj][m][n], 0, 0, 0); __builtin_amdgcn_s_setprio(0); } while (0)
#define PG8_WAIT_V(n) asm volatile("s_waitcnt vmcnt(" #n ")" ::: "memory")
#define PG8_WAIT_L(n) asm volatile("s_waitcnt lgkmcnt(" #n ")" ::: "memory")
#define PG8_BAR __builtin_amdgcn_s_barrier()
#define PG8_SCHED __builtin_amdgcn_sched_barrier(0)
    Unit cur, nxt; int ui = 0;
    if (!S.next(0, cur)) return;
    f32x4 acc[2][2][4][2];
#pragma unroll
    for (int a = 0; a < 2; ++a)
#pragma unroll
        for (int b = 0; b < 2; ++b)
#pragma unroll
            for (int m = 0; m < 4; ++m)
#pragma unroll
                for (int n = 0; n < 2; ++n) acc[a][b][m][n] = (f32x4){0.f, 0.f, 0.f, 0.f};
    bf16x8 At[4][2], B0[2][2], B1[2][2];
    const char* cA = (const char*)g.A + (size_t)cur.pm * tstep; const char* cB = (const char*)g.Bt + (size_t)cur.pn * tstep + (cur.pn >= g.skip_pn ? (size_t)g.skip_rows * K * 2 : (size_t)0);
    S.a_ready(cur);
    PG8_STAGE(PG8_SB(0, 0), cB, voffB); PG8_STAGE(PG8_SA(0, 0), cA, voffA); PG8_STAGE(PG8_SB(0, 1), cB + hstep, voffB); PG8_STAGE(PG8_SA(0, 1), cA + hstep, voffA);
    if (wr == 1) PG8_BAR;
    PG8_WAIT_V(4); PG8_BAR;
    PG8_STAGE(PG8_SB(1, 0), cB + kstep, voffB); PG8_STAGE(PG8_SA(1, 0), cA + kstep, voffA); PG8_STAGE(PG8_SB(1, 1), cB + hstep + kstep, voffB);
    PG8_WAIT_V(6); PG8_BAR;
    PG8_STAMP();
    for (;;) {
        const bool has_next = S.next(ui + 1, nxt);
        const char* nA = has_next ? (const char*)g.A + (size_t)nxt.pm * tstep : cA; const char* nB = has_next ? (const char*)g.Bt + (size_t)nxt.pn * tstep + (nxt.pn >= g.skip_pn ? (size_t)g.skip_rows * K * 2 : (size_t)0) : cB;
        for (int t = 0; t < nt; t += 2) {
            const bool last = (t == nt - 2);
            const char* a1 = cA + (size_t)(t + 1) * kstep;
            const char* a2 = last ? nA : cA + (size_t)(t + 2) * kstep; const char* b2 = last ? nB : cB + (size_t)(t + 2) * kstep;
            const char* a3 = a2 + kstep; const char* b3 = b2 + kstep;
            if (last && has_next) S.a_ready(nxt);
            PG8_LDB(B0, 0, 0); PG8_SCHED; PG8_LDA(At, 0, 0); PG8_STAGE(PG8_SA(1, 1), a1 + hstep, voffA);
            PG8_WAIT_L(8); PG8_BAR; PG8_WAIT_L(0); PG8_MMA(0, 0, At, B0); PG8_BAR; PG8_SCHED;
            PG8_LDB(B1, 0, 1); PG8_STAGE(PG8_SB(0, 0), b2, voffB);
            PG8_BAR; PG8_WAIT_L(0); PG8_MMA(0, 1, At, B1); PG8_BAR;
            PG8_LDA(At, 0, 1); PG8_STAGE(PG8_SA(0, 0), a2, voffA);
            PG8_BAR; PG8_WAIT_L(0); PG8_MMA(1, 0, At, B0); PG8_BAR; PG8_SCHED;
            PG8_STAGE(PG8_SB(0, 1), b2 + hstep, voffB);
            PG8_WAIT_V(6); PG8_BAR; PG8_MMA(1, 1, At, B1); PG8_BAR;
            PG8_LDB(B0, 1, 0); PG8_SCHED; PG8_LDA(At, 1, 0); PG8_STAGE(PG8_SA(0, 1), a2 + hstep, voffA);
            PG8_WAIT_L(8); PG8_BAR; PG8_WAIT_L(0); PG8_MMA(0, 0, At, B0); PG8_BAR; PG8_SCHED;
            PG8_LDB(B1, 1, 1); PG8_STAGE(PG8_SB(1, 0), b3, voffB);
            PG8_BAR; PG8_WAIT_L(0); PG8_MMA(0, 1, At, B1); PG8_BAR;
            PG8_LDA(At, 1, 1); PG8_STAGE(PG8_SA(1, 0), a3, voffA);
            PG8_BAR; PG8_WAIT_L(0); PG8_MMA(1, 0, At, B0); PG8_BAR; PG8_SCHED;
            PG8_STAGE(PG8_SB(1, 1), b3 + hstep, voffB);
            PG8_WAIT_V(6); PG8_BAR; PG8_MMA(1, 1, At, B1); PG8_BAR;
        }
        PG8_STAMP();
        if constexpr (!Epi::AFTER_DRAIN) { E(acc, cur, wr, wc, fr, fq); S.done(cur); }
        PG8_STAMP();
        if (!has_next) break;
#pragma unroll
        for (int a = 0; a < 2; ++a)
#pragma unroll
            for (int b = 0; b < 2; ++b)
#pragma unroll
                for (int m = 0; m < 4; ++m)
#pragma unroll
                    for (int n = 0; n < 2; ++n) acc[a][b][m][n] = (f32x4){0.f, 0.f, 0.f, 0.f};
        cur = nxt; cA = nA; cB = nB; ++ui;
    }
    PG8_WAIT_V(0);
    if (wr == 0) PG8_BAR;
    PG8_BAR;
    if constexpr (Epi::AFTER_DRAIN) { E.fused(acc, cur, wr, wc, fr, fq, lds, wid, lane); S.done(cur); }
    PG8_STAMP();
    if (STAMP && wid == 0) { stamps[lane] = lane < nts ? (((unsigned long long)(unsigned)ts_hi << 32) | (unsigned)ts_lo) : 0ull;
        if (lane == 62) stamps[62] = rt_entry; if (lane == 63) stamps[63] = (unsigned long long)wall_clock64(); }
#undef PG8_STAMP
#undef PG8_SA
#undef PG8_SB
#undef PG8_STAGE
#undef PG8_LDA
#undef PG8_LDB
#undef PG8_MMA
#undef PG8_WAIT_V
#undef PG8_WAIT_L
#undef PG8_BAR
#undef PG8_SCHED
}
}

using pg8::bf16_t; using pg8::bf16x8; using pg8::f32x4; using pg8::u32x4;
#define LAS __attribute__((address_space(3)))
typedef float f32x2 __attribute__((ext_vector_type(2)));
typedef unsigned u32x2 __attribute__((ext_vector_type(2)));

constexpr int DM = 1024, NBP = 8, TT = 2048, MP = NBP * TT, NS = 128, MT = MP + NS, DIN = 5136;
constexpr int C_XA = 0, C_ZA = 1024, C_Q = 2048, C_K = 2560, C_V = 3072, C_GLR = 4096, C_ZG = 4112;
constexpr float EPS = 1e-6f;
constexpr int LDS_BYTES = 139264;
constexpr size_t O_YP = 0, O_YS = 16777216, O_HP = O_YS + 131072, O_CP = O_HP + 8192, O_GP = O_CP + 24576, O_HS = O_GP + 1048576, O_CS = O_HS + 131072, O_GS = O_CS + 393216;
constexpr size_t O_SLOC = 8388608;
constexpr size_t al(size_t x) { return (x + 255) & ~(size_t)255; }
constexpr size_t W_PART = 0;
constexpr size_t W_PARTS = al(W_PART + (size_t)MP * 16 * 4);
constexpr size_t W_ADA = al(W_PARTS + (size_t)128 * 64 * 4);
constexpr size_t W_WTIN = al(W_ADA + (size_t)136 * 3072 * 4);
constexpr size_t W_WTOUT = al(W_WTIN + (size_t)DIN * 1024 * 2);
constexpr size_t W_WTGX = al(W_WTOUT + (size_t)1024 * 2048 * 2);
constexpr size_t W_WTGA = al(W_WTGX + (size_t)8 * 128 * 128 * 2);
constexpr size_t W_HNS = al(W_WTGA + (size_t)8 * 128 * 128 * 2);
constexpr size_t W_GLRP = al(W_HNS + (size_t)128 * 1024 * 2);
constexpr size_t W_ZS = al(W_GLRP + (size_t)MP * 16 * 4);
constexpr size_t W_MIX = al(W_ZS + (size_t)NS * DIN * 4);
constexpr size_t W_SEGA = al(W_MIX + (size_t)MT * 2048 * 2);
constexpr size_t W_SEGH = al(W_SEGA + (size_t)8 * 4 * 1024 * 4);
constexpr size_t W_DSEG = al(W_SEGH + (size_t)8 * 4 * 1024 * 4);
constexpr size_t W_Z = al(W_DSEG + (size_t)8 * 4 * 8 * 128 * 4);
constexpr size_t W_END = W_Z + (size_t)MP * DIN * 2;

enum { I_XP = 0, I_XS, I_STH, I_STC, I_STG, I_CP, I_CS, I_GN, I_WADA, I_BADA, I_WIN, I_CW, I_CB, I_WGX, I_BGX, I_WGA, I_BGA, I_LAM, I_WG2, I_BG2, I_GGLA, I_WOUT, I_GFIN, N_IN };
struct Params { const float* in[N_IN]; float* out; unsigned char* ws; int ph_lo, ph_hi; };

__device__ __forceinline__ float bf2f(unsigned b) { return __uint_as_float(b << 16); }
__device__ __forceinline__ float bflo(unsigned u) { return __uint_as_float(u << 16); }
__device__ __forceinline__ float bfhi(unsigned u) { return __uint_as_float(u & 0xffff0000u); }
__device__ __forceinline__ unsigned pk2(float lo, float hi) { unsigned r; asm("v_cvt_pk_bf16_f32 %0, %1, %2" : "=v"(r) : "v"(lo), "v"(hi)); return r; }
__device__ __forceinline__ bf16_t f2bf(float x) { return (bf16_t)(pk2(x, 0.f) & 0xffffu); }
__device__ __forceinline__ float sigm(float x) { return __builtin_amdgcn_rcpf(1.f + __expf(-x)); }
__device__ __forceinline__ float silu(float x) { return x * sigm(x); }
__device__ __forceinline__ float logsig(float x) { return fminf(x, 0.f) - log1pf(__expf(-fabsf(x))); }
__device__ __forceinline__ float logsig_fast(float x) { return -__logf(1.f + __expf(-fmaxf(x, -80.f))); }
__device__ __forceinline__ float wave_sum(float v) {
#pragma unroll
    for (int o = 1; o < 64; o <<= 1) v += __shfl_xor(v, o);
    return v;
}
#define MFMA16(a, b, c) __builtin_amdgcn_mfma_f32_16x16x32_bf16((a), (b), (c), 0, 0, 0)

__device__ __forceinline__ void phase0(const Params& p, LAS unsigned char* lds) {
    const int tid = threadIdx.x, lane = tid & 63, wave = __builtin_amdgcn_readfirstlane(tid >> 6);
    constexpr int I_IN = 16 * 161, I_OUT = 32 * 32, I_G = 128, TI = I_IN + I_OUT + I_G, NTB = (TI + 7) / 8, NADA = 192;
    for (int jb = blockIdx.x; jb < NTB + NADA; jb += gridDim.x) {
        if (jb >= NADA) {
            const int it = (jb - NADA) * 8 + wave;
            LAS float* scr = (LAS float*)(lds + wave * 8448);
            const float* W = p.in[I_WIN]; bf16_t* WT = (bf16_t*)(p.ws + W_WTIN); int K = 1024, N = DIN, nblk = 161, item = it;
            if (it >= I_IN + I_OUT) {
                const int r = it - I_IN - I_OUT, g = r >> 6, nn = (r >> 3) & 7;
                W = (g ? p.in[I_WGA] : p.in[I_WGX]) + nn * 16384; WT = (bf16_t*)(p.ws + (g ? W_WTGA : W_WTGX)) + nn * 16384; K = 128; N = 128; nblk = 4; item = r & 7;
            } else if (it >= I_IN) { W = p.in[I_WOUT]; WT = (bf16_t*)(p.ws + W_WTOUT); K = 2048; N = 1024; nblk = 32; item = it - I_IN; }
            const bool valid = it < TI;
            const int kb = item / nblk, nb = item % nblk, k0 = 64 * kb, n0 = 32 * nb;
            if (valid) {
                const int n = n0 + (lane & 31);
#pragma unroll 8
                for (int i = 0; i < 32; ++i) { const int kk = 2 * i + (lane >> 5); scr[kk * 33 + (lane & 31)] = (n < N) ? W[(size_t)(k0 + kk) * N + n] : 0.f; }
            }
            __syncthreads();
            if (valid) {
                const int c = lane & 7;
#pragma unroll
                for (int j = 0; j < 4; ++j) { const int n = (lane >> 3) + 8 * j; const LAS float* s = scr + (8 * c) * 33 + n;
                    if (n0 + n < N) { u32x4 o; o.x = pk2(s[0], s[33]); o.y = pk2(s[66], s[99]); o.z = pk2(s[132], s[165]); o.w = pk2(s[198], s[231]);
                        *(u32x4*)(WT + (size_t)(n0 + n) * K + k0 + 8 * c) = o; } }
            }
            __syncthreads();
        } else {
            const int ai = jb, c0 = ai * 16, fr = lane & 15, fq = lane >> 4;
            LAS f32x4* red = (LAS f32x4*)lds;
            f32x4 acc[9];
#pragma unroll
            for (int rt = 0; rt < 9; ++rt) acc[rt] = (f32x4){0.f, 0.f, 0.f, 0.f};
#pragma unroll 1
            for (int ks = 0; ks < 4; ++ks) { const int k0 = wave * 128 + ks * 32 + 8 * fq;
                float wv[8];
#pragma unroll
                for (int j = 0; j < 8; ++j) wv[j] = p.in[I_WADA][(size_t)(k0 + j) * 3072 + c0 + fr];
                bf16x8 bfrag; { u32x4 t; t.x = pk2(wv[0], wv[1]); t.y = pk2(wv[2], wv[3]); t.z = pk2(wv[4], wv[5]); t.w = pk2(wv[6], wv[7]); bfrag = __builtin_bit_cast(bf16x8, t); }
#pragma unroll
                for (int rt = 0; rt < 9; ++rt) { int r = rt * 16 + fr; r = r < 136 ? r : 135;
                    const float* cr = (r < 8 ? p.in[I_CP] + r * 1024 : p.in[I_CS] + (r - 8) * 1024) + k0;
                    const f32x4 c0v = *(const f32x4*)cr, c1v = *(const f32x4*)(cr + 4);
                    u32x4 t; t.x = pk2(silu(c0v.x), silu(c0v.y)); t.y = pk2(silu(c0v.z), silu(c0v.w)); t.z = pk2(silu(c1v.x), silu(c1v.y)); t.w = pk2(silu(c1v.z), silu(c1v.w));
                    acc[rt] = MFMA16(__builtin_bit_cast(bf16x8, t), bfrag, acc[rt]); }
            }
#pragma unroll
            for (int rt = 0; rt < 9; ++rt) red[(wave * 9 + rt) * 64 + lane] = acc[rt];
            __syncthreads();
            float* ada = (float*)(p.ws + W_ADA);
            for (int o = tid; o < 9 * 64; o += 512) { const int rt = o >> 6, l = o & 63; f32x4 sum = red[rt * 64 + l];
#pragma unroll
                for (int w = 1; w < 8; ++w) sum += red[(w * 9 + rt) * 64 + l];
                const float bias = p.in[I_BADA][c0 + (l & 15)];
#pragma unroll
                for (int j = 0; j < 4; ++j) { const int r = rt * 16 + 4 * (l >> 4) + j; if (r < 136) ada[(size_t)r * 3072 + c0 + (l & 15)] = sum[j] + bias; } }
            __syncthreads();
        }
    }
}

__device__ __forceinline__ void phase1(const Params& p) {
    const int tid = threadIdx.x, lane = tid & 63, wave = __builtin_amdgcn_readfirstlane(tid >> 6);
    const float* ada = (const float*)(p.ws + W_ADA);
    const int step = gridDim.x * 8;
    int row = blockIdx.x * 8 + wave;
    f32x4 v[4];
    if (row < MT) { const float* xr = row < MP ? p.in[I_XP] + (size_t)row * 1024 : p.in[I_XS] + (size_t)(row - MP) * 1024;
#pragma unroll
        for (int j = 0; j < 4; ++j) v[j] = *(const f32x4*)(xr + 4 * (lane + 64 * j)); }
    while (row < MT) {
        const int nrow = row + step; f32x4 nv[4];
        if (nrow < MT) { const float* xr = nrow < MP ? p.in[I_XP] + (size_t)nrow * 1024 : p.in[I_XS] + (size_t)(nrow - MP) * 1024;
#pragma unroll
            for (int j = 0; j < 4; ++j) nv[j] = *(const f32x4*)(xr + 4 * (lane + 64 * j)); }
        const bool pr = row < MP;
        const int ar = pr ? (row >> 11) : 8 + row - MP;
        bf16_t* hr = pr ? (bf16_t*)p.out + (size_t)row * 1024 : (bf16_t*)(p.ws + W_HNS) + (size_t)(row - MP) * 1024;
        float ss = 0.f;
#pragma unroll
        for (int j = 0; j < 4; ++j) ss += v[j].x * v[j].x + v[j].y * v[j].y + v[j].z * v[j].z + v[j].w * v[j].w;
        ss = wave_sum(ss);
        const float rstd = __builtin_amdgcn_rsqf(ss * (1.f / 1024.f) + EPS);
#pragma unroll
        for (int j = 0; j < 4; ++j) { const int col = 4 * (lane + 64 * j);
            const f32x4 g = *(const f32x4*)(p.in[I_GN] + col), sh = *(const f32x4*)(ada + (size_t)ar * 3072 + col), sc = *(const f32x4*)(ada + (size_t)ar * 3072 + 1024 + col);
            const f32x4 hv = v[j] * rstd * g * (sc + 1.f) + sh;
            u32x2 o; o.x = pk2(hv.x, hv.y); o.y = pk2(hv.z, hv.w);
            *(u32x2*)(hr + col) = o; }
#pragma unroll
        for (int j = 0; j < 4; ++j) v[j] = nv[j];
        row = nrow;
    }
}

__device__ __forceinline__ f32x4 skinny_tile(const bf16_t* A, int lda, const bf16_t* Bt, int ldb, int K, int lane) {
    const int fr = lane & 15, fq = lane >> 4;
    const bf16x8* pa = (const bf16x8*)(A + (size_t)fr * lda + fq * 8);
    const bf16x8* pb = (const bf16x8*)(Bt + (size_t)fr * ldb + fq * 8);
    f32x4 acc = {0.f, 0.f, 0.f, 0.f};
#pragma unroll 16
    for (int s = 0; s < K / 32; ++s) acc = MFMA16(pa[s * 4], pb[s * 4], acc);
    return acc;
}

struct EpiZ {
    static constexpr bool PERM = true, AFTER_DRAIN = false;
    bf16_t* Z;
    __device__ __forceinline__ void operator()(const f32x4 (&acc)[2][2][4][2], const pg8::Unit& u, int wr, int wc, int fr, int fq) const {
        const int row0 = u.pm * 256 + wr * 64 + fr, col0 = u.pn * 256 + (u.pn >= 16 ? 16 : 0) + wc * 32 + 8 * fq;
#pragma unroll
        for (int ai = 0; ai < 2; ++ai)
#pragma unroll
            for (int m = 0; m < 4; ++m) { bf16_t* rowp = Z + (size_t)(row0 + ai * 128 + m * 16) * DIN + col0;
#pragma unroll
                for (int bj = 0; bj < 2; ++bj) { const f32x4 v0 = acc[ai][bj][m][0], v1 = acc[ai][bj][m][1];
                    u32x4 o; o.x = pk2(v0[0], v0[1]); o.y = pk2(v0[2], v0[3]); o.z = pk2(v1[0], v1[1]); o.w = pk2(v1[2], v1[3]);
                    *(u32x4*)(rowp + bj * 128) = o; } }
    }
};
struct EpiY {
    static constexpr bool PERM = false, AFTER_DRAIN = false;
    const float* x; const float* ada; float* y; float* part;
    __device__ __forceinline__ void operator()(const f32x4 (&acc)[2][2][4][2], const pg8::Unit& u, int wr, int wc, int fr, int fq) const {
        const int row0 = u.pm * 256 + wr * 64 + fr, col0 = u.pn * 256 + wc * 32 + 4 * fq, bb = u.pm >> 3;
        f32x4 gv[2][2];
#pragma unroll
        for (int bj = 0; bj < 2; ++bj)
#pragma unroll
            for (int n = 0; n < 2; ++n) gv[bj][n] = *(const f32x4*)(ada + (size_t)bb * 3072 + 2048 + col0 + bj * 128 + n * 16);
#pragma unroll
        for (int ai = 0; ai < 2; ++ai)
#pragma unroll
            for (int m = 0; m < 4; ++m) { const int row = row0 + ai * 128 + m * 16; const float* xr = x + (size_t)row * 1024 + col0; float* yr = y + (size_t)row * 1024 + col0; float ss = 0.f;
#pragma unroll
                for (int bj = 0; bj < 2; ++bj)
#pragma unroll
                    for (int n = 0; n < 2; ++n) { const f32x4 xv = *(const f32x4*)(xr + bj * 128 + n * 16); const f32x4 v = xv + gv[bj][n] * acc[ai][bj][m][n];
                        *(f32x4*)(yr + bj * 128 + n * 16) = v; ss += v.x * v.x + v.y * v.y + v.z * v.z + v.w * v.w; }
                ss += __shfl_xor(ss, 16); ss += __shfl_xor(ss, 32);
                if (fq == 0) part[(size_t)row * 16 + u.pn * 4 + wc] = ss; }
    }
};

__device__ __forceinline__ void phase2(const Params& p, LAS unsigned char* lds) {
    const int tid = threadIdx.x, lane = tid & 63, wave = __builtin_amdgcn_readfirstlane(tid >> 6), fr = lane & 15, fq = lane >> 4;
    const bf16_t* hnp = (const bf16_t*)p.out; const bf16_t* hns = (const bf16_t*)(p.ws + W_HNS); const bf16_t* wt = (const bf16_t*)(p.ws + W_WTIN);
    float* glrp = (float*)(p.ws + W_GLRP); float* zs = (float*)(p.ws + W_ZS);
    for (int i = blockIdx.x * 8 + wave; i < 1024 + 8 * 321; i += gridDim.x * 8) {
        if (i < 1024) { const f32x4 a = skinny_tile(hnp + (size_t)i * 16 * 1024, 1024, wt + (size_t)C_GLR * 1024, 1024, 1024, lane);
#pragma unroll
            for (int j = 0; j < 4; ++j) glrp[(size_t)(i * 16 + 4 * fq + j) * 16 + fr] = a[j];
        } else { const int r = i - 1024, rt = r / 321, ct = r % 321; const f32x4 a = skinny_tile(hns + (size_t)rt * 16 * 1024, 1024, wt + (size_t)ct * 16 * 1024, 1024, 1024, lane);
#pragma unroll
            for (int j = 0; j < 4; ++j) zs[(size_t)(rt * 16 + 4 * fq + j) * DIN + ct * 16 + fr] = a[j]; }
    }
    __syncthreads();
    pg8::Gemm g{hnp, wt, MP, 5120, 1024, 16, 16};
    pg8::StaticOrder S; S.init(MP, 5120, (int)gridDim.x, (int)blockIdx.x);
    EpiZ E{(bf16_t*)(p.ws + W_Z)};
    pg8::gemm_phase<EpiZ, pg8::StaticOrder, false>(lds, g, S, E, nullptr);
    __syncthreads();
}

template <int PASS>
__device__ __forceinline__ void lru_quarter(const Params& p, LAS unsigned char* lds, int b, int n, int q) {
    const int tid = threadIdx.x, lane = tid & 63, wave = __builtin_amdgcn_readfirstlane(tid >> 6), fr = lane & 15, fq = lane >> 4;
    LAS unsigned char* XC = lds;
    LAS float* XCF = (LAS float*)(lds + 17408);
    LAS float* AA = (LAS float*)(lds + 17408 + 32768);
    LAS float* UU = (LAS float*)(lds + 17408 + 65536);
    LAS float* SP = (LAS float*)(lds + 17408 + 98304);
    LAS float* SH = SP + 1024;
    const bf16_t* z = (const bf16_t*)(p.ws + W_Z);
    float* segA = (float*)(p.ws + W_SEGA); float* segH = (float*)(p.ws + W_SEGH);
    bf16_t* mix = (bf16_t*)(p.ws + W_MIX);
    const size_t rowb = (size_t)b * TT;
    const int ch2 = n * 128 + 2 * lane;
    const bf16_t* zb = z + rowb * DIN + C_XA + ch2;
    f32x2 cw[4];
#pragma unroll
    for (int j = 0; j < 4; ++j) cw[j] = *(const f32x2*)(p.in[I_CW] + j * 1024 + ch2);
    const f32x2 cb = *(const f32x2*)(p.in[I_CB] + ch2);
    bf16x8 bx[4], ba[4];
    {
        const bf16_t* wx = (const bf16_t*)(p.ws + W_WTGX) + (size_t)(n * 128 + wave * 16 + fr) * 128 + fq * 8;
        const bf16_t* wa = (const bf16_t*)(p.ws + W_WTGA) + (size_t)(n * 128 + wave * 16 + fr) * 128 + fq * 8;
#pragma unroll
        for (int ks = 0; ks < 4; ++ks) { bx[ks] = *(const bf16x8*)(wx + ks * 32); ba[ks] = *(const bf16x8*)(wa + ks * 32); }
    }
    const int eg = wave * 16 + fr, chg = n * 128 + eg;
    const float bgx = p.in[I_BGX][chg], bga = p.in[I_BGA][chg], c8 = 8.f * logsig(p.in[I_LAM][chg]);
    f32x2 hc = {0.f, 0.f}, Pq = {1.f, 1.f};
    if (PASS == 2) {
        f32x2 A3[3], H3[3];
#pragma unroll
        for (int qq = 0; qq < 3; ++qq) { A3[qq] = (f32x2){0.f, 0.f}; H3[qq] = (f32x2){0.f, 0.f};
            if (qq < q) { A3[qq] = *(const f32x2*)(segA + (size_t)(b * 4 + qq) * 1024 + ch2); H3[qq] = *(const f32x2*)(segH + (size_t)(b * 4 + qq) * 1024 + ch2); } }
#pragma unroll
        for (int qq = 0; qq < 3; ++qq) if (qq < q) hc = A3[qq] * hc + H3[qq];
    }
    unsigned xraw[11];
    {
        const int tb = q * 512 + wave * 8 - 3;
#pragma unroll
        for (int i = 0; i < 11; ++i) { const int t = tb + i; xraw[i] = (t >= 0) ? *(const unsigned*)(zb + (size_t)t * DIN) : 0u; }
    }
#pragma unroll 1
    for (int seg = 0; seg < 8; ++seg) {
        const int t0 = q * 512 + seg * 64;
        {
            f32x2 xv[11];
#pragma unroll
            for (int i = 0; i < 11; ++i) { xv[i].x = bflo(xraw[i]); xv[i].y = bfhi(xraw[i]); }
#pragma unroll
            for (int r = 0; r < 8; ++r) { const f32x2 xc = cb + cw[0] * xv[r] + cw[1] * xv[r + 1] + cw[2] * xv[r + 2] + cw[3] * xv[r + 3]; const int row = wave * 8 + r;
                *(LAS f32x2*)(XCF + row * 128 + 2 * lane) = xc; *(LAS unsigned*)(XC + row * 272 + lane * 4) = pk2(xc.x, xc.y); }
            if (PASS == 2 && q == 3 && seg == 7 && wave == 7) {
#pragma unroll
                for (int j = 0; j < 3; ++j) *(f32x2*)(p.out + O_CP + (size_t)b * 3072 + j * 1024 + ch2) = xv[8 + j]; }
            if (seg < 7) {
                const int tb = t0 + 64 + wave * 8 - 3;
#pragma unroll
                for (int i = 0; i < 11; ++i) xraw[i] = *(const unsigned*)(zb + (size_t)(tb + i) * DIN);
            }
        }
        unsigned zraw[8];
        if (PASS == 2) {
#pragma unroll
            for (int r = 0; r < 8; ++r) zraw[r] = *(const unsigned*)(z + (rowb + t0 + wave * 8 + r) * DIN + C_ZA + ch2);
        }
        __syncthreads();
        f32x4 ax[4], aa[4];
#pragma unroll
        for (int rt = 0; rt < 4; ++rt) { ax[rt] = (f32x4){0.f, 0.f, 0.f, 0.f}; aa[rt] = (f32x4){0.f, 0.f, 0.f, 0.f}; }
#pragma unroll
        for (int rt = 0; rt < 4; ++rt)
#pragma unroll
            for (int ks = 0; ks < 4; ++ks) { const bf16x8 a = *(const LAS bf16x8*)(XC + (rt * 16 + fr) * 272 + ks * 64 + fq * 16); ax[rt] = MFMA16(a, bx[ks], ax[rt]); aa[rt] = MFMA16(a, ba[ks], aa[rt]); }
#pragma unroll
        for (int rt = 0; rt < 4; ++rt)
#pragma unroll
            for (int j = 0; j < 4; ++j) { const int row = rt * 16 + 4 * fq + j; const float gx = sigm(ax[rt][j] + bgx), ga = sigm(aa[rt][j] + bga), a = __expf(c8 * ga);
                AA[row * 128 + eg] = a; UU[row * 128 + eg] = __builtin_amdgcn_sqrtf(fmaxf(1.f - a * a, 0.f)) * gx * XCF[row * 128 + eg]; }
        __syncthreads();
        {
            f32x2 P = {1.f, 1.f}, H = {0.f, 0.f};
#pragma unroll
            for (int r = 0; r < 8; ++r) { const f32x2 a = *(const LAS f32x2*)(AA + (wave * 8 + r) * 128 + 2 * lane), u = *(const LAS f32x2*)(UU + (wave * 8 + r) * 128 + 2 * lane); H = a * H + u; P = P * a; }
            *(LAS f32x2*)(SP + wave * 128 + 2 * lane) = P; *(LAS f32x2*)(SH + wave * 128 + 2 * lane) = H;
            __syncthreads();
            f32x2 hs = hc;
            f32x2 he = hc;
#pragma unroll
            for (int w = 0; w < 8; ++w) { const f32x2 sp = *(const LAS f32x2*)(SP + w * 128 + 2 * lane), sh = *(const LAS f32x2*)(SH + w * 128 + 2 * lane);
                he = sp * he + sh; if (w < wave) hs = he; if (PASS == 1) Pq = Pq * sp; }
            if (PASS == 2) {
#pragma unroll
                for (int r = 0; r < 8; ++r) { const int row = wave * 8 + r;
                    const f32x2 a = *(const LAS f32x2*)(AA + row * 128 + 2 * lane), u = *(const LAS f32x2*)(UU + row * 128 + 2 * lane);
                    hs = a * hs + u;
                    *(unsigned*)(mix + (rowb + t0 + row) * 2048 + ch2) = pk2(hs.x * silu(bflo(zraw[r])), hs.y * silu(bfhi(zraw[r]))); }
            }
            hc = he;
        }
        __syncthreads();
    }
    if (PASS == 1) { if (wave == 0) { *(f32x2*)(segA + (size_t)(b * 4 + q) * 1024 + ch2) = Pq; *(f32x2*)(segH + (size_t)(b * 4 + q) * 1024 + ch2) = hc; } }
    else if (q == 3 && wave == 0) *(f32x2*)(p.out + O_HP + (size_t)b * 1024 + ch2) = hc;
}

template <int PASS>
__device__ __forceinline__ void gla_item(const Params& p, LAS unsigned char* lds, int b, int h, int seg) {
    const int tid0 = threadIdx.x, lane = tid0 & 63, wave = __builtin_amdgcn_readfirstlane(tid0 >> 6), fr0 = lane & 15, fq0 = lane >> 4;
    int tid = tid0, fr = fr0, fq = fq0;
    LAS unsigned char* QI = lds;
    LAS unsigned char* KI = lds + 8704;
    LAS unsigned char* KDT = lds + 17408;
    LAS unsigned char* VT = lds + 27648;
    LAS unsigned char* AM = lds + 48128;
    LAS unsigned char* ST = lds + 50688;
    LAS float* GLR = (LAS float*)(lds + 120320);
    LAS float* PT = (LAS float*)(lds + 122368);
    LAS float* DEC = (LAS float*)(lds + 126464);
    LAS float* RSS = (LAS float*)(lds + 126976);
    const bf16_t* z = (const bf16_t*)(p.ws + W_Z);
    const float* glrp = (const float*)(p.ws + W_GLRP);
    float* Sloc = p.out + O_SLOC; float* Dseg = (float*)(p.ws + W_DSEG);
    bf16_t* mix = (bf16_t*)(p.ws + W_MIX);
    const int bh = b * 4 + h; int kk0 = 2 * lane;
    LAS float* WG = (LAS float*)(lds + 127488);
    for (int i = tid; i < 2048; i += 512) WG[i] = p.in[I_WG2][(i >> 7) * 512 + h * 128 + (i & 127)];
    const f32x2 bg = *(const f32x2*)(p.in[I_BG2] + h * 128 + kk0);
    f32x4 S[2][8];
#pragma unroll
    for (int a = 0; a < 2; ++a)
#pragma unroll
        for (int k = 0; k < 8; ++k) S[a][k] = (f32x4){0.f, 0.f, 0.f, 0.f};
    f32x2 ltot = {0.f, 0.f};
    if (PASS == 2) {
        for (int s = 0; s < seg; ++s) {
            const float* Sl = Sloc + (size_t)(bh * 8 + s) * 32768; const float* Dv = Dseg + (size_t)(bh * 8 + s) * 128;
#pragma unroll
            for (int kt = 0; kt < 8; ++kt) { const f32x4 d = *(const f32x4*)(Dv + 16 * kt + 4 * fq);
#pragma unroll
                for (int a = 0; a < 2; ++a) S[a][kt] = d * S[a][kt] + *(const f32x4*)(Sl + (size_t)((a * 8 + kt) * 512 + tid) * 4); }
        }
#pragma unroll
        for (int a = 0; a < 2; ++a)
#pragma unroll
            for (int kt = 0; kt < 8; ++kt) { u32x2 o; o.x = pk2(S[a][kt][0], S[a][kt][1]); o.y = pk2(S[a][kt][2], S[a][kt][3]);
                *(LAS u32x2*)(ST + (16 * (2 * wave + a) + fr) * 272 + (16 * kt + 4 * fq) * 2) = o; }
    }
    float glrv; unsigned qv[4], kv[4], vraw[2][4];
#define GLA_LOAD(cc) do { const size_t r0_ = (size_t)b * TT + seg * 256 + (cc) * 32; glrv = glrp[r0_ * 16 + tid0]; \
        _Pragma("unroll") for (int r = 0; r < 4; ++r) { const bf16_t* zr = z + (r0_ + 4 * wave + r) * DIN + h * 128 + 2 * lane; kv[r] = *(const unsigned*)(zr + C_K); qv[r] = (PASS == 2) ? *(const unsigned*)(zr + C_Q) : 0u; } \
        _Pragma("unroll") for (int i = 0; i < 2; ++i) { const int idx = tid0 + i * 512, vp = idx & 127, tg = idx >> 7; \
            _Pragma("unroll") for (int r = 0; r < 4; ++r) vraw[i][r] = *(const unsigned*)(z + (r0_ + 4 * tg + r) * DIN + C_V + h * 256 + 2 * vp); } } while (0)
    GLA_LOAD(0);
    for (int c = 0; c < 8; ++c) {
        tid = tid0; fr = fr0; fq = fq0; kk0 = 2 * lane;
        asm volatile("" : "+v"(tid), "+v"(fr), "+v"(fq), "+v"(kk0));
        const size_t row0 = (size_t)b * TT + seg * 256 + c * 32;
        GLR[tid] = glrv;
        __syncthreads();
        f32x2 cs[4];
        {
            f32x2 run = {0.f, 0.f};
#pragma unroll
            for (int r = 0; r < 4; ++r) { f32x2 x = bg;
#pragma unroll
                for (int q4 = 0; q4 < 4; ++q4) { const f32x4 g = *(const LAS f32x4*)(GLR + (4 * wave + r) * 16 + 4 * q4);
                    x += g.x * *(const LAS f32x2*)(WG + (4 * q4) * 128 + kk0) + g.y * *(const LAS f32x2*)(WG + (4 * q4 + 1) * 128 + kk0)
                       + g.z * *(const LAS f32x2*)(WG + (4 * q4 + 2) * 128 + kk0) + g.w * *(const LAS f32x2*)(WG + (4 * q4 + 3) * 128 + kk0); }
                run.x += logsig_fast(x.x) * 0.0625f; run.y += logsig_fast(x.y) * 0.0625f; cs[r] = run; }
            *(LAS f32x2*)(PT + wave * 128 + kk0) = run;
        }
        __syncthreads();
        f32x2 off = {0.f, 0.f}, tot = {0.f, 0.f};
#pragma unroll
        for (int w = 0; w < 8; ++w) { const f32x2 t = *(const LAS f32x2*)(PT + w * 128 + kk0); tot += t; if (w < wave) off += t; }
        ltot += tot;
        if (wave == 0) { f32x2 d; d.x = __expf(tot.x); d.y = __expf(tot.y); *(LAS f32x2*)(DEC + kk0) = d; }
        {
            float kdx[4], kdy[4];
#pragma unroll
            for (int r = 0; r < 4; ++r) { const f32x2 bb = off + cs[r]; const float k0 = bflo(kv[r]), k1 = bfhi(kv[r]);
                kdx[r] = k0 * __expf(tot.x - bb.x); kdy[r] = k1 * __expf(tot.y - bb.y);
                if (PASS == 2) { const float q0 = bflo(qv[r]) * 0.08838834764831845f, q1 = bfhi(qv[r]) * 0.08838834764831845f;
                    *(LAS unsigned*)(QI + (4 * wave + r) * 272 + kk0 * 2) = pk2(q0 * __expf(bb.x), q1 * __expf(bb.y));
                    *(LAS unsigned*)(KI + (4 * wave + r) * 272 + kk0 * 2) = pk2(k0 * __expf(-bb.x), k1 * __expf(-bb.y)); } }
            u32x2 o; o.x = pk2(kdx[0], kdx[1]); o.y = pk2(kdx[2], kdx[3]); *(LAS u32x2*)(KDT + kk0 * 80 + wave * 8) = o;
            o.x = pk2(kdy[0], kdy[1]); o.y = pk2(kdy[2], kdy[3]); *(LAS u32x2*)(KDT + (kk0 + 1) * 80 + wave * 8) = o;
        }
#pragma unroll
        for (int i = 0; i < 2; ++i) { const int idx = tid + i * 512, vp = idx & 127, tg = idx >> 7;
            u32x2 lo, hi;
            lo.x = (vraw[i][0] & 0xffffu) | (vraw[i][1] << 16); lo.y = (vraw[i][2] & 0xffffu) | (vraw[i][3] << 16);
            hi.x = (vraw[i][0] >> 16) | (vraw[i][1] & 0xffff0000u); hi.y = (vraw[i][2] >> 16) | (vraw[i][3] & 0xffff0000u);
            *(LAS u32x2*)(VT + (2 * vp) * 80 + tg * 8) = lo; *(LAS u32x2*)(VT + (2 * vp + 1) * 80 + tg * 8) = hi; }
        if (c < 7) GLA_LOAD(c + 1);
        __syncthreads();
        const int ct = wave >> 2;
        f32x4 o4[4];
        if (PASS == 2) {
            if (wave < 4) {
                const int st = wave >> 1, cti = wave & 1;
                f32x4 am = {0.f, 0.f, 0.f, 0.f};
#pragma unroll
                for (int ks = 0; ks < 4; ++ks) { const bf16x8 ka = *(const LAS bf16x8*)(KI + (16 * st + fr) * 272 + ks * 64 + fq * 16), qb = *(const LAS bf16x8*)(QI + (16 * cti + fr) * 272 + ks * 64 + fq * 16);
                    am = MFMA16(ka, qb, am); }
                const int cc = 16 * cti + fr; float m[4];
#pragma unroll
                for (int j = 0; j < 4; ++j) m[j] = (16 * st + 4 * fq + j <= cc) ? am[j] : 0.f;
                u32x2 o; o.x = pk2(m[0], m[1]); o.y = pk2(m[2], m[3]);
                *(LAS u32x2*)(AM + cc * 80 + (16 * st + 4 * fq) * 2) = o;
            }
            __syncthreads();
            const bf16x8 amf = *(const LAS bf16x8*)(AM + (16 * ct + fr) * 80 + fq * 16);
            float ss = 0.f;
#pragma unroll
            for (int i = 0; i < 4; ++i) { const int vt = 4 * (wave & 3) + i;
                const bf16x8 vf = *(const LAS bf16x8*)(VT + (16 * vt + fr) * 80 + fq * 16); o4[i] = MFMA16(vf, amf, ((f32x4){0.f, 0.f, 0.f, 0.f})); }
#pragma unroll
            for (int ks = 0; ks < 4; ++ks) { const bf16x8 qf = *(const LAS bf16x8*)(QI + (16 * ct + fr) * 272 + ks * 64 + fq * 16);
#pragma unroll
                for (int i = 0; i < 4; ++i) { const int vt = 4 * (wave & 3) + i; const bf16x8 sf = *(const LAS bf16x8*)(ST + (16 * vt + fr) * 272 + ks * 64 + fq * 16); o4[i] = MFMA16(sf, qf, o4[i]); } }
#pragma unroll
            for (int i = 0; i < 4; ++i) ss += o4[i].x * o4[i].x + o4[i].y * o4[i].y + o4[i].z * o4[i].z + o4[i].w * o4[i].w;
            ss += __shfl_xor(ss, 16); ss += __shfl_xor(ss, 32);
            if (fq == 0) RSS[(16 * ct + fr) * 4 + (wave & 3)] = ss;
            __syncthreads();
            const int cc = 16 * ct + fr; const f32x4 r4 = *(const LAS f32x4*)(RSS + cc * 4);
            const float rstd = 1.0f / sqrtf((r4.x + r4.y + r4.z + r4.w) * (1.f / 256.f) + EPS);
            const size_t row = row0 + cc;
#pragma unroll
            for (int i = 0; i < 4; ++i) { const int col = h * 256 + 16 * (4 * (wave & 3) + i) + 4 * fq;
                const f32x4 g = *(const f32x4*)(p.in[I_GGLA] + col); const u32x2 zg = *(const u32x2*)(z + row * DIN + C_ZG + col);
                u32x2 o; o.x = pk2(o4[i].x * rstd * g.x * silu(bflo(zg.x)), o4[i].y * rstd * g.y * silu(bfhi(zg.x)));
                o.y = pk2(o4[i].z * rstd * g.z * silu(bflo(zg.y)), o4[i].w * rstd * g.w * silu(bfhi(zg.y)));
                *(u32x2*)(mix + row * 2048 + 1024 + col) = o; }
        }
        {
            bf16x8 vf[2];
#pragma unroll
            for (int a = 0; a < 2; ++a) vf[a] = *(const LAS bf16x8*)(VT + (16 * (2 * wave + a) + fr) * 80 + fq * 16);
#pragma unroll
            for (int kt = 0; kt < 8; ++kt) { const f32x4 d = *(const LAS f32x4*)(DEC + 16 * kt + 4 * fq); const bf16x8 kf = *(const LAS bf16x8*)(KDT + (16 * kt + fr) * 80 + fq * 16);
#pragma unroll
                for (int a = 0; a < 2; ++a) S[a][kt] = MFMA16(kf, vf[a], S[a][kt] * d); }
        }
        if (PASS == 2) {
#pragma unroll
            for (int a = 0; a < 2; ++a)
#pragma unroll
                for (int kt = 0; kt < 8; ++kt) { u32x2 o; o.x = pk2(S[a][kt][0], S[a][kt][1]); o.y = pk2(S[a][kt][2], S[a][kt][3]);
                    *(LAS u32x2*)(ST + (16 * (2 * wave + a) + fr) * 272 + (16 * kt + 4 * fq) * 2) = o; }
        }
        __syncthreads();
    }
    if (PASS == 1) {
        float* Sl = Sloc + (size_t)(bh * 8 + seg) * 32768;
#pragma unroll
        for (int a = 0; a < 2; ++a)
#pragma unroll
            for (int kt = 0; kt < 8; ++kt) *(f32x4*)(Sl + (size_t)((a * 8 + kt) * 512 + tid) * 4) = S[a][kt];
        if (wave == 0) { f32x2 d; d.x = __expf(ltot.x); d.y = __expf(ltot.y); *(f32x2*)(Dseg + (size_t)(bh * 8 + seg) * 128 + kk0) = d; }
    } else if (seg == 7) {
        float* gb = p.out + O_GP + (size_t)bh * 32768 + (size_t)(4 * fq) * 256 + 32 * wave + fr;
#pragma unroll
        for (int kt = 0; kt < 8; ++kt)
#pragma unroll
            for (int j = 0; j < 4; ++j)
#pragma unroll
                for (int a = 0; a < 2; ++a) gb[(16 * kt + j) * 256 + 16 * a] = S[a][kt][j];
    }
}

__device__ __forceinline__ void gla_sample_item(const Params& p, LAS unsigned char* lds, int b, int h) {
    const int tid = threadIdx.x, lane = tid & 63, wave = __builtin_amdgcn_readfirstlane(tid >> 6);
    LAS float* AL = (LAS float*)lds; LAS float* KK = AL + 128; LAS float* QQ = AL + 256; LAS float* OS = AL + 384; LAS float* RS = OS + 2048;
    const float* zs = (const float*)(p.ws + W_ZS) + (size_t)b * DIN;
    if (tid < 128) { const int kk = tid; float x = p.in[I_BG2][h * 128 + kk];
#pragma unroll
        for (int r = 0; r < 16; ++r) x += zs[C_GLR + r] * p.in[I_WG2][r * 512 + h * 128 + kk];
        AL[kk] = __expf(logsig(x) * 0.0625f); KK[kk] = zs[C_K + h * 128 + kk]; QQ[kk] = zs[C_Q + h * 128 + kk] * 0.08838834764831845f; }
    __syncthreads();
    const f32x4 vv = *(const f32x4*)(zs + C_V + h * 256 + 4 * lane);
    const float* S0 = p.in[I_STG] + (size_t)(b * 4 + h) * 32768; float* Sn = p.out + O_GS + (size_t)(b * 4 + h) * 32768;
    f32x4 o = {0.f, 0.f, 0.f, 0.f};
#pragma unroll 8
    for (int i = 0; i < 16; ++i) { const int kk = wave * 16 + i; const f32x4 s = *(const f32x4*)(S0 + kk * 256 + 4 * lane); const f32x4 sn = s * AL[kk] + vv * KK[kk];
        *(f32x4*)(Sn + kk * 256 + 4 * lane) = sn; o += sn * QQ[kk]; }
    *(LAS f32x4*)(OS + wave * 256 + 4 * lane) = o;
    __syncthreads();
    float ov = 0.f;
    if (tid < 256) {
#pragma unroll
        for (int g = 0; g < 8; ++g) ov += OS[g * 256 + tid];
        const float ss = wave_sum(ov * ov); if (lane == 0) RS[wave] = ss; }
    __syncthreads();
    if (tid < 256) { const float rstd = 1.0f / sqrtf((RS[0] + RS[1] + RS[2] + RS[3]) * (1.f / 256.f) + EPS);
        const float y = ov * rstd * p.in[I_GGLA][h * 256 + tid] * silu(zs[C_ZG + h * 256 + tid]);
        ((bf16_t*)(p.ws + W_MIX))[(size_t)(MP + b) * 2048 + 1024 + h * 256 + tid] = f2bf(y); }
    __syncthreads();
}
__device__ __forceinline__ void lru_sample_item(const Params& p, LAS unsigned char* lds, int n, int rg) {
    const int tid = threadIdx.x;
    LAS float* XS = (LAS float*)lds;
    LAS float* RED = XS + 512;
    const float* zsb = (const float*)(p.ws + W_ZS);
    {
        const int r = tid >> 7, d = tid & 127, b = rg * 4 + r, ch = n * 128 + d;
        const float xa = zsb[(size_t)b * DIN + C_XA + ch];
        const float* cv = p.in[I_STC] + (size_t)b * 3072 + ch; const float c0 = cv[0], c1 = cv[1024], c2 = cv[2048];
        const float* cw = p.in[I_CW] + ch;
        XS[r * 128 + d] = p.in[I_CB][ch] + cw[0] * c0 + cw[1024] * c1 + cw[2048] * c2 + cw[3072] * xa;
        float* oc = p.out + O_CS + (size_t)b * 3072 + ch; oc[0] = c1; oc[1024] = c2; oc[2048] = xa;
    }
    __syncthreads();
    {
        const int e = tid & 127, q = tid >> 7;
        float gx[4] = {0.f, 0.f, 0.f, 0.f}, ga[4] = {0.f, 0.f, 0.f, 0.f};
        const float* wx = p.in[I_WGX] + (size_t)n * 16384 + (size_t)(q * 32) * 128 + e; const float* wa = p.in[I_WGA] + (size_t)n * 16384 + (size_t)(q * 32) * 128 + e;
#pragma unroll 8
        for (int d = 0; d < 32; ++d) { const float a = wx[d * 128], c = wa[d * 128];
#pragma unroll
            for (int r = 0; r < 4; ++r) { const float x = XS[r * 128 + q * 32 + d]; gx[r] += x * a; ga[r] += x * c; } }
#pragma unroll
        for (int r = 0; r < 4; ++r) { RED[((q * 2 + 0) * 4 + r) * 128 + e] = gx[r]; RED[((q * 2 + 1) * 4 + r) * 128 + e] = ga[r]; }
    }
    __syncthreads();
    {
        const int r = tid >> 7, e = tid & 127, b = rg * 4 + r, ch = n * 128 + e;
        float sx = p.in[I_BGX][ch], sa = p.in[I_BGA][ch];
#pragma unroll
        for (int q = 0; q < 4; ++q) { sx += RED[((q * 2 + 0) * 4 + r) * 128 + e]; sa += RED[((q * 2 + 1) * 4 + r) * 128 + e]; }
        const float gxv = sigm(sx), gav = sigm(sa), la = 8.f * gav * logsig(p.in[I_LAM][ch]);
        const float hn = __expf(la) * p.in[I_STH][(size_t)b * 1024 + ch] + sqrtf(-expm1f(2.f * la)) * gxv * XS[r * 128 + e];
        p.out[O_HS + (size_t)b * 1024 + ch] = hn;
        ((bf16_t*)(p.ws + W_MIX))[(size_t)(MP + b) * 2048 + ch] = f2bf(hn * silu(zsb[(size_t)b * DIN + C_ZA + ch]));
    }
    __syncthreads();
}

__global__ void __launch_bounds__(512, 2) fwd_kernel(Params p) {
    extern __shared__ __attribute__((aligned(16))) unsigned char shm[];
    LAS unsigned char* lds = (LAS unsigned char*)shm;
    cg::grid_group grid = cg::this_grid();
    const int G = (int)gridDim.x, bid = (int)blockIdx.x, tid = threadIdx.x, lane = tid & 63, wave = __builtin_amdgcn_readfirstlane(tid >> 6);
#ifndef SKIPMASK
#define SKIPMASK 0
#endif
#define PH(k) if (!((SKIPMASK >> (k)) & 1) && p.ph_lo <= (k) && (k) < p.ph_hi)
#define SEAM(k) if (p.ph_lo < (k)) grid.sync()
    PH(0) { phase0(p, lds); }
    PH(1) { SEAM(1); phase1(p); }
    PH(2) { SEAM(2); phase2(p, lds); }
    PH(3) { SEAM(3);
        for (int i = bid; i < 224; i += G) gla_item<1>(p, lds, (i / 7) >> 2, (i / 7) & 3, i % 7);
        __syncthreads();
        for (int i = bid; i < 512; i += G) gla_sample_item(p, lds, i >> 2, i & 3);
        for (int i = bid; i < 256; i += G) lru_sample_item(p, lds, i & 7, i >> 3);
        for (int i = bid; i < 256; i += G) lru_quarter<1>(p, lds, i >> 5, (i >> 2) & 7, i & 3);
    }
    PH(4) { SEAM(4);
        for (int i = bid; i < 256; i += G) gla_item<2>(p, lds, i >> 5, (i >> 3) & 3, i & 7);
        {
            const int fr = lane & 15, fq = lane >> 4;
            const bf16_t* mixs = (const bf16_t*)(p.ws + W_MIX) + (size_t)MP * 2048; const bf16_t* wo = (const bf16_t*)(p.ws + W_WTOUT);
            const float* ada = (const float*)(p.ws + W_ADA); float* parts = (float*)(p.ws + W_PARTS);
            for (int i = bid * 8 + wave; i < 512; i += G * 8) { const int rt = i >> 6, ct = i & 63;
                const f32x4 a = skinny_tile(mixs + (size_t)rt * 16 * 2048, 2048, wo + (size_t)ct * 16 * 2048, 2048, 2048, lane);
#pragma unroll
                for (int j = 0; j < 4; ++j) { const int r = rt * 16 + 4 * fq + j, c = ct * 16 + fr;
                    const float v = p.in[I_XS][(size_t)r * 1024 + c] + ada[(size_t)(8 + r) * 3072 + 2048 + c] * a[j];
                    p.out[O_YS + (size_t)r * 1024 + c] = v;
                    float ss = v * v; ss += __shfl_xor(ss, 1); ss += __shfl_xor(ss, 2); ss += __shfl_xor(ss, 4); ss += __shfl_xor(ss, 8);
                    if (fr == 0) parts[r * 64 + ct] = ss; }
            }
        }
        __syncthreads();
        for (int i = bid; i < 256; i += G) lru_quarter<2>(p, lds, i >> 5, (i >> 2) & 7, i & 3);
    }
    PH(5) { SEAM(5);
        __syncthreads();
        pg8::Gemm g{(const bf16_t*)(p.ws + W_MIX), (const bf16_t*)(p.ws + W_WTOUT), MP, 1024, 2048, 1 << 30, 0};
        pg8::StaticOrder S; S.init(MP, 1024, G, bid);
        EpiY E{p.in[I_XP], (const float*)(p.ws + W_ADA), p.out + O_YP, (float*)(p.ws + W_PART)};
        pg8::gemm_phase<EpiY, pg8::StaticOrder, false>(lds, g, S, E, nullptr);
    }
    PH(6) { SEAM(6);
        const float* part = (const float*)(p.ws + W_PART); const float* parts = (const float*)(p.ws + W_PARTS);
        const int step = G * 8; int row = bid * 8 + wave;
        f32x4 v[4]; float ps = 0.f;
        if (row < MT) { const float* yr = p.out + (size_t)row * 1024;
#pragma unroll
            for (int j = 0; j < 4; ++j) v[j] = *(const f32x4*)(yr + 4 * (lane + 64 * j));
            ps = row < MP ? (lane < 16 ? part[(size_t)row * 16 + lane] : 0.f) : parts[(row - MP) * 64 + lane]; }
        while (row < MT) {
            const int nrow = row + step; f32x4 nv[4]; float nps = 0.f;
            if (nrow < MT) { const float* yr = p.out + (size_t)nrow * 1024;
#pragma unroll
                for (int j = 0; j < 4; ++j) nv[j] = *(const f32x4*)(yr + 4 * (lane + 64 * j));
                nps = nrow < MP ? (lane < 16 ? part[(size_t)nrow * 16 + lane] : 0.f) : parts[(nrow - MP) * 64 + lane]; }
            const float rstd = __builtin_amdgcn_rsqf(wave_sum(ps) * (1.f / 1024.f) + EPS);
            float* yr = p.out + (size_t)row * 1024;
#pragma unroll
            for (int j = 0; j < 4; ++j) { const int col = 4 * (lane + 64 * j); const f32x4 g = *(const f32x4*)(p.in[I_GFIN] + col); *(f32x4*)(yr + col) = v[j] * rstd * g; }
#pragma unroll
            for (int j = 0; j < 4; ++j) v[j] = nv[j];
            ps = nps; row = nrow;
        }
    }
}

#ifndef N_LAUNCH
#define N_LAUNCH 1
#endif
extern "C" void kernel_launch(void* const* d_in, const int* in_sizes, int n_in, void* d_out, int out_size, void* d_ws, size_t ws_size, hipStream_t stream) {
    static int grid = 0;
    if (grid == 0) {
        int dev = 0, cus = 0, per_cu = 0;
        if (n_in != N_IN || ws_size < W_END) { fprintf(stderr, "kernel_launch: unexpected problem: n_in %d ws %zu (need %zu)\n", n_in, ws_size, (size_t)W_END); grid = -1; return; }
        hipGetDevice(&dev); hipDeviceGetAttribute(&cus, hipDeviceAttributeMultiprocessorCount, dev);
        if (hipFuncSetAttribute((const void*)fwd_kernel, hipFuncAttributeMaxDynamicSharedMemorySize, LDS_BYTES) != hipSuccess) { fprintf(stderr, "kernel_launch: hipFuncSetAttribute failed\n"); grid = -1; return; }
        if (hipOccupancyMaxActiveBlocksPerMultiprocessor(&per_cu, (const void*)fwd_kernel, 512, LDS_BYTES) != hipSuccess || per_cu < 1) { fprintf(stderr, "kernel_launch: occupancy query says %d blocks per CU\n", per_cu); (void)hipGetLastError(); grid = -1; return; }
        grid = cus;
    }
    if (grid < 0) return;
    Params p; memset(&p, 0, sizeof(p));
    for (int i = 0; i < N_IN; ++i) p.in[i] = (const float*)d_in[i];
    p.out = (float*)d_out; p.ws = (unsigned char*)d_ws;
#ifdef PROBE_SEQ
    { const int seq[] = PROBE_SEQ; for (int ph : seq) { p.ph_lo = ph; p.ph_hi = ph + 1; hipLaunchKernelGGL(fwd_kernel, dim3(grid), dim3(512), LDS_BYTES, stream, p); } }
#elif N_LAUNCH == 1
    p.ph_lo = 0; p.ph_hi = 7;
    void* args[] = {&p};
    hipError_t e = hipLaunchCooperativeKernel((const void*)fwd_kernel, dim3(grid), dim3(512), args, LDS_BYTES, stream);
    if (e != hipSuccess) fprintf(stderr, "kernel_launch: cooperative launch failed: %s (grid %d)\n", hipGetErrorString(e), grid);
#else
    for (int ph = 0; ph < 7; ++ph) { p.ph_lo = ph; p.ph_hi = ph + 1; hipLaunchKernelGGL(fwd_kernel, dim3(grid), dim3(512), LDS_BYTES, stream, p); }
#endif
}
```

```cpp
#include <hip/hip_runtime.h>
#include <hip/hip_cooperative_groups.h>
#include <cstdio>
#include <cstdint>
#include <cstring>
namespace cg = cooperative_groups;

namespace pg8 {
#define PG8_LAS __attribute__((address_space(3)))
typedef unsigned short bf16_t;
typedef short bf16x8 __attribute__((ext_vector_type(8)));
typedef float f32x4 __attribute__((ext_vector_type(4)));
typedef unsigned u32x4 __attribute__((ext_vector_type(4)));
constexpr int BM = 256, BK = 64, HALF = 128, HTB = HALF * BK * 2  , STAGE_BYTES = 8 * HTB, NXCD = 8, WGM = 8;

__host__ __device__ __forceinline__ int lds_byte(int r, int c) { const int st = (r >> 4) * 2 + (c >> 5), rr = r & 15, cc = c & 31, ob = rr * 64 + cc * 2; return st * 1024 + (ob ^ (((ob >> 9) & 1) << 5)); }
__host__ __device__ __forceinline__ void stage_rc(int b, int& R, int& C) { const int st = b / 1024, sb = b % 1024, swz = sb ^ (((sb >> 9) & 1) << 5); R = (st >> 1) * 16 + swz / 64; C = (st & 1) * 32 + (swz % 64) / 2; }
__host__ __device__ __forceinline__ int perm32(int rho) { const int n = rho >> 4, i = rho & 15; return 8 * (i >> 2) + 4 * n + (i & 3); }

struct Unit { int pm, pn; };
struct Gemm { const bf16_t* A; const bf16_t* Bt; int M, N, K; int skip_pn, skip_rows; };

struct StaticOrder {
    int nM, nN, nwg, G, c;
    __host__ __device__ void init(int M, int N, int G_, int c_) { nM = M / BM; nN = N / BM; nwg = nM * nN; G = G_; c = c_; }
    __host__ __device__ bool next(int i, Unit& u) const {
        const long L = (long)i * G + c; if (L >= nwg) return false;
        int wgid = (int)L; { const int q = nwg / NXCD, r = nwg % NXCD, xcd = wgid % NXCD, off = wgid / NXCD; wgid = (xcd < r ? xcd * (q + 1) : r * (q + 1) + (xcd - r) * q) + off; }
        const int nig = WGM * nN, gid = wgid / nig, fm = gid * WGM, gsz = (nM - fm) < WGM ? (nM - fm) : WGM;
        u.pm = fm + ((wgid % nig) % gsz); u.pn = (wgid % nig) / gsz; return true;
    }
    __device__ __forceinline__ void a_ready(const Unit&) const {}
    __device__ __forceinline__ void done(const Unit&) const {}
};
__device__ __forceinline__ unsigned cvt_pk_bf16(float lo, float hi) { unsigned r; asm volatile("v_cvt_pk_bf16_f32 %0, %1, %2" : "=v"(r) : "v"(lo), "v"(hi)); return r; }
template <class Epi, class Sched, bool STAMP = false>
__device__ __forceinline__ void gemm_phase(PG8_LAS unsigned char* lds, const Gemm g, const Sched& S, const Epi& E, unsigned long long* stamps) {
    const int tid = threadIdx.x, wid = __builtin_amdgcn_readfirstlane(tid >> 6), lane = tid & 63, wr = wid >> 2, wc = wid & 3, fr = lane & 15, fq = lane >> 4;
    const int K = g.K, nt = K / BK;
    int ts_lo = 0, ts_hi = 0, nts = 0; const unsigned long long rt_entry = STAMP ? (unsigned long long)wall_clock64() : 0ull;
#define PG8_STAMP() do { if (STAMP && wid == 0 && nts < 64) { const unsigned long long _c = (unsigned long long)clock64(); \
        ts_lo = (lane == nts) ? (int)(unsigned)_c : ts_lo; ts_hi = (lane == nts) ? (int)(unsigned)(_c >> 32) : ts_hi; ++nts; } } while (0)
    PG8_STAMP();
    unsigned voffA[2], voffB[2];
#pragma unroll
    for (int i = 0; i < 2; ++i) { int R, C; stage_rc(tid * 16 + i * 8192, R, C); const int Rb = Epi::PERM ? ((R & ~31) + perm32(R & 31)) : R;
        voffA[i] = (unsigned)(R * K + C) * 2u; voffB[i] = (unsigned)(Rb * K + C) * 2u; }
    const size_t kstep = (size_t)(BK * 2);
    const size_t hstep = (size_t)HALF * K * 2;
    const size_t tstep = 2 * hstep;
    const unsigned ldsw = (unsigned)wid * 1024u;
    const int aoff = lds_byte(wr * 64 + fr, fq * 8), boff = lds_byte(wc * 32 + fr, fq * 8);
#define PG8_SA(b, h) (((b) * 2 + (h)) * HTB)
#define PG8_SB(b, h) ((4 + (b) * 2 + (h)) * HTB)
#define PG8_STAGE(bufoff, gbase, voff) do { _Pragma("unroll") for (int _i = 0; _i < 2; ++_i) \
        __builtin_amdgcn_global_load_lds((const unsigned*)((const char*)(gbase) + (voff)[_i]), (PG8_LAS unsigned*)(lds + (bufoff) + ldsw + _i * 8192), 16, 0, 0); } while (0)
#define PG8_LDA(dst, b, h) do { _Pragma("unroll") for (int m = 0; m < 4; ++m) _Pragma("unroll") for (int k = 0; k < 2; ++k) dst[m][k] = *(const PG8_LAS bf16x8*)(lds + PG8_SA(b, h) + aoff + m * 2048 + k * 1024); } while (0)
#define PG8_LDB(dst, b, h) do { _Pragma("unroll") for (int n = 0; n < 2; ++n) _Pragma("unroll") for (int k = 0; k < 2; ++k) dst[n][k] = *(const PG8_LAS bf16x8*)(lds + PG8_SB(b, h) + boff + n * 2048 + k * 1024); } while (0)
#define PG8_MMA(ai, bj, At, Bt) do { __builtin_amdgcn_s_setprio(1); _Pragma("unroll") for (int m = 0; m < 4; ++m) _Pragma("unroll") for (int n = 0; n < 2; ++n) _Pragma("unroll") for (int k = 0; k < 2; ++k) \
        acc[ai][bj][m][n] = __builtin_amdgcn_mfma_f32_16x16x32_bf16(Bt[n][k], At[m][k], acc[ai][bj][m][n], 0, 0, 0); __builtin_amdgcn_s_setprio(0); } while (0)
#define PG8_WAIT_V(n) asm volatile("s_waitcnt vmcnt(" #n ")" ::: "memory")
#define PG8_WAIT_L(n) asm volatile("s_waitcnt lgkmcnt(" #n ")" ::: "memory")
#define PG8_BAR __builtin_amdgcn_s_barrier()
#define PG8_SCHED __builtin_amdgcn_sched_barrier(0)
    Unit cur, nxt; int ui = 0;
    if (!S.next(0, cur)) return;
    f32x4 acc[2][2][4][2];
#pragma unroll
    for (int a = 0; a < 2; ++a)
#pragma unroll
        for (int b = 0; b < 2; ++b)
#pragma unroll
            for (int m = 0; m < 4; ++m)
#pragma unroll
                for (int n = 0; n < 2; ++n) acc[a][b][m][n] = (f32x4){0.f, 0.f, 0.f, 0.f};
    bf16x8 At[4][2], B0[2][2], B1[2][2];
    const char* cA = (const char*)g.A + (size_t)cur.pm * tstep; const char* cB = (const char*)g.Bt + (size_t)cur.pn * tstep + (cur.pn >= g.skip_pn ? (size_t)g.skip_rows * K * 2 : (size_t)0);
    S.a_ready(cur);
    PG8_STAGE(PG8_SB(0, 0), cB, voffB); PG8_STAGE(PG8_SA(0, 0), cA, voffA); PG8_STAGE(PG8_SB(0, 1), cB + hstep, voffB); PG8_STAGE(PG8_SA(0, 1), cA + hstep, voffA);
    if (wr == 1) PG8_BAR;
    PG8_WAIT_V(4); PG8_BAR;
    PG8_STAGE(PG8_SB(1, 0), cB + kstep, voffB); PG8_STAGE(PG8_SA(1, 0), cA + kstep, voffA); PG8_STAGE(PG8_SB(1, 1), cB + hstep + kstep, voffB);
    PG8_WAIT_V(6); PG8_BAR;
    PG8_STAMP();
    for (;;) {
        const bool has_next = S.next(ui + 1, nxt);
        const char* nA = has_next ? (const char*)g.A + (size_t)nxt.pm * tstep : cA; const char* nB = has_next ? (const char*)g.Bt + (size_t)nxt.pn * tstep + (nxt.pn >= g.skip_pn ? (size_t)g.skip_rows * K * 2 : (size_t)0) : cB;
        for (int t = 0; t < nt; t += 2) {
            const bool last = (t == nt - 2);
            const char* a1 = cA + (size_t)(t + 1) * kstep;
            const char* a2 = last ? nA : cA + (size_t)(t + 2) * kstep; const char* b2 = last ? nB : cB + (size_t)(t + 2) * kstep;
            const char* a3 = a2 + kstep; const char* b3 = b2 + kstep;
            if (last && has_next) S.a_ready(nxt);
            PG8_LDB(B0, 0, 0); PG8_SCHED; PG8_LDA(At, 0, 0); PG8_STAGE(PG8_SA(1, 1), a1 + hstep, voffA);
            PG8_WAIT_L(8); PG8_BAR; PG8_WAIT_L(0); PG8_MMA(0, 0, At, B0); PG8_BAR; PG8_SCHED;
            PG8_LDB(B1, 0, 1); PG8_STAGE(PG8_SB(0, 0), b2, voffB);
            PG8_BAR; PG8_WAIT_L(0); PG8_MMA(0, 1, At, B1); PG8_BAR;
            PG8_LDA(At, 0, 1); PG8_STAGE(PG8_SA(0, 0), a2, voffA);
            PG8_BAR; PG8_WAIT_L(0); PG8_MMA(1, 0, At, B0); PG8_BAR; PG8_SCHED;
            PG8_STAGE(PG8_SB(0, 1), b2 + hstep, voffB);
            PG8_WAIT_V(6); PG8_BAR; PG8_MMA(1, 1, At, B1); PG8_BAR;
            PG8_LDB(B0, 1, 0); PG8_SCHED; PG8_LDA(At, 1, 0); PG8_STAGE(PG8_SA(0, 1), a2 + hstep, voffA);
            PG8_WAIT_L(8); PG8_BAR; PG8_WAIT_L(0); PG8_MMA(0, 0, At, B0); PG8_BAR; PG8_SCHED;
            PG8_LDB(B1, 1, 1); PG8_STAGE(PG8_SB(1, 0), b3, voffB);
            PG8_BAR; PG8_WAIT_L(0); PG8_MMA(0, 1, At, B1); PG8_BAR;
            PG8_LDA(At, 1, 1); PG8_STAGE(PG8_SA(1, 0), a3, voffA);
            PG8_BAR; PG8_WAIT_L(0); PG8_MMA(1, 0, At, B0); PG8_BAR; PG8_SCHED;
            PG8_STAGE(PG8_SB(1, 1), b3 + hstep, voffB);
            PG8_WAIT_V(6); PG8_BAR; PG8_MMA(1, 1, At, B1); PG8_BAR;
        }
        PG8_STAMP();
        if constexpr (!Epi::AFTER_DRAIN) { E(acc, cur, wr, wc, fr, fq); S.done(cur); }
        PG8_STAMP();
        if (!has_next) break;
#pragma unroll
        for (int a = 0; a < 2; ++a)
#pragma unroll
            for (int b = 0; b < 2; ++b)
#pragma unroll
                for (int m = 0; m < 4; ++m)
#pragma unroll
                    for (int n = 0; n < 2; ++n) acc[a][b][m][n] = (f32x4){0.f, 0.f, 0.f, 0.f};
        cur = nxt; cA = nA; cB = nB; ++ui;
    }
    PG8_WAIT_V(0);
    if (wr == 0) PG8_BAR;
    PG8_BAR;
    if constexpr (Epi::AFTER_DRAIN) { E.fused(acc, cur, wr, wc, fr, fq, lds, wid, lane); S.done(cur); }
    PG8_STAMP();
    if (STAMP && wid == 0) { stamps[lane] = lane < nts ? (((unsigned long long)(unsigned)ts_hi << 32) | (unsigned)ts_lo) : 0ull;
        if (lane == 62) stamps[62] = rt_entry; if (lane == 63) stamps[63] = (unsigned long long)wall_clock64(); }
#undef PG8_STAMP
#undef PG8_SA
#undef PG8_SB
#undef PG8_STAGE
#undef PG8_LDA
#undef PG8_LDB
#undef PG8_MMA
#undef PG8_WAIT_V
#undef PG8_WAIT_L
#undef PG8_BAR
#undef PG8_SCHED
}
}

using pg8::bf16_t; using pg8::bf16x8; using pg8::f32x4; using pg8::u32x4;
#define LAS __attribute__((address_space(3)))
typedef float f32x2 __attribute__((ext_vector_type(2)));
typedef unsigned u32x2 __attribute__((ext_vector_type(2)));

constexpr int DM = 1024, NBP = 8, TT = 2048, MP = NBP * TT, NS = 128, MT = MP + NS, DIN = 5136;
constexpr int C_XA = 0, C_ZA = 1024, C_Q = 2048, C_K = 2560, C_V = 3072, C_GLR = 4096, C_ZG = 4112;
constexpr float EPS = 1e-6f;
constexpr int LDS_BYTES = 139264;
constexpr size_t O_YP = 0, O_YS = 16777216, O_HP = O_YS + 131072, O_CP = O_HP + 8192, O_GP = O_CP + 24576, O_HS = O_GP + 1048576, O_CS = O_HS + 131072, O_GS = O_CS + 393216;
constexpr size_t O_SLOC = 8388608;
constexpr size_t al(size_t x) { return (x + 255) & ~(size_t)255; }
constexpr size_t W_PART = 0;
constexpr size_t W_PARTS = al(W_PART + (size_t)MP * 16 * 4);
constexpr size_t W_ADA = al(W_PARTS + (size_t)128 * 64 * 4);
constexpr size_t W_WTIN = al(W_ADA + (size_t)136 * 3072 * 4);
constexpr size_t W_WTOUT = al(W_WTIN + (size_t)DIN * 1024 * 2);
constexpr size_t W_WTGX = al(W_WTOUT + (size_t)1024 * 2048 * 2);
constexpr size_t W_WTGA = al(W_WTGX + (size_t)8 * 128 * 128 * 2);
constexpr size_t W_HNS = al(W_WTGA + (size_t)8 * 128 * 128 * 2);
constexpr size_t W_GLRP = al(W_HNS + (size_t)128 * 1024 * 2);
constexpr size_t W_ZS = al(W_GLRP + (size_t)MP * 16 * 4);
constexpr size_t W_MIX = al(W_ZS + (size_t)NS * DIN * 4);
constexpr size_t W_SEGA = al(W_MIX + (size_t)MT * 2048 * 2);
constexpr size_t W_SEGH = al(W_SEGA + (size_t)8 * 4 * 1024 * 4);
constexpr size_t W_DSEG = al(W_SEGH + (size_t)8 * 4 * 1024 * 4);
constexpr size_t W_Z = al(W_DSEG + (size_t)8 * 4 * 8 * 128 * 4);
constexpr size_t W_END = W_Z + (size_t)MP * DIN * 2;

enum { I_XP = 0, I_XS, I_STH, I_STC, I_STG, I_CP, I_CS, I_GN, I_WADA, I_BADA, I_WIN, I_CW, I_CB, I_WGX, I_BGX, I_WGA, I_BGA, I_LAM, I_WG2, I_BG2, I_GGLA, I_WOUT, I_GFIN, N_IN };
struct Params { const float* in[N_IN]; float* out; unsigned char* ws; int ph_lo, ph_hi; };

__device__ __forceinline__ float bf2f(unsigned b) { return __uint_as_float(b << 16); }
__device__ __forceinline__ float bflo(unsigned u) { return __uint_as_float(u << 16); }
__device__ __forceinline__ float bfhi(unsigned u) { return __uint_as_float(u & 0xffff0000u); }
__device__ __forceinline__ unsigned pk2(float lo, float hi) { unsigned r; asm("v_cvt_pk_bf16_f32 %0, %1, %2" : "=v"(r) : "v"(lo), "v"(hi)); return r; }
__device__ __forceinline__ bf16_t f2bf(float x) { return (bf16_t)(pk2(x, 0.f) & 0xffffu); }
__device__ __forceinline__ float sigm(float x) { return __builtin_amdgcn_rcpf(1.f + __expf(-x)); }
__device__ __forceinline__ float silu(float x) { return x * sigm(x); }
__device__ __forceinline__ float logsig(float x) { return fminf(x, 0.f) - log1pf(__expf(-fabsf(x))); }
__device__ __forceinline__ float logsig_fast(float x) { return -__logf(1.f + __expf(-fmaxf(x, -80.f))); }
__device__ __forceinline__ float wave_sum(float v) {
#pragma unroll
    for (int o = 1; o < 64; o <<= 1) v += __shfl_xor(v, o);
    return v;
}
#define MFMA16(a, b, c) __builtin_amdgcn_mfma_f32_16x16x32_bf16((a), (b), (c), 0, 0, 0)

__device__ __forceinline__ void phase0(const Params& p, LAS unsigned char* lds) {
    const int tid = threadIdx.x, lane = tid & 63, wave = __builtin_amdgcn_readfirstlane(tid >> 6);
    constexpr int I_IN = 16 * 161, I_OUT = 32 * 32, I_G = 128, TI = I_IN + I_OUT + I_G, NTB = (TI + 7) / 8, NADA = 192;
    for (int jb = blockIdx.x; jb < NTB + NADA; jb += gridDim.x) {
        if (jb >= NADA) {
            const int it = (jb - NADA) * 8 + wave;
            LAS float* scr = (LAS float*)(lds + wave * 8448);
            const float* W = p.in[I_WIN]; bf16_t* WT = (bf16_t*)(p.ws + W_WTIN); int K = 1024, N = DIN, nblk = 161, item = it;
            if (it >= I_IN + I_OUT) {
                const int r = it - I_IN - I_OUT, g = r >> 6, nn = (r >> 3) & 7;
                W = (g ? p.in[I_WGA] : p.in[I_WGX]) + nn * 16384; WT = (bf16_t*)(p.ws + (g ? W_WTGA : W_WTGX)) + nn * 16384; K = 128; N = 128; nblk = 4; item = r & 7;
            } else if (it >= I_IN) { W = p.in[I_WOUT]; WT = (bf16_t*)(p.ws + W_WTOUT); K = 2048; N = 1024; nblk = 32; item = it - I_IN; }
            const bool valid = it < TI;
            const int kb = item / nblk, nb = item % nblk, k0 = 64 * kb, n0 = 32 * nb;
            if (valid) {
                const int n = n0 + (lane & 31);
#pragma unroll 8
                for (int i = 0; i < 32; ++i) { const int kk = 2 * i + (lane >> 5); scr[kk * 33 + (lane & 31)] = (n < N) ? W[(size_t)(k0 + kk) * N + n] : 0.f; }
            }
            __syncthreads();
            if (valid) {
                const int c = lane & 7;
#pragma unroll
                for (int j = 0; j < 4; ++j) { const int n = (lane >> 3) + 8 * j; const LAS float* s = scr + (8 * c) * 33 + n;
                    if (n0 + n < N) { u32x4 o; o.x = pk2(s[0], s[33]); o.y = pk2(s[66], s[99]); o.z = pk2(s[132], s[165]); o.w = pk2(s[198], s[231]);
                        *(u32x4*)(WT + (size_t)(n0 + n) * K + k0 + 8 * c) = o; } }
            }
            __syncthreads();
        } else {
            const int ai = jb, c0 = ai * 16, fr = lane & 15, fq = lane >> 4;
            LAS f32x4* red = (LAS f32x4*)lds;
            f32x4 acc[9];
#pragma unroll
            for (int rt = 0; rt < 9; ++rt) acc[rt] = (f32x4){0.f, 0.f, 0.f, 0.f};
#pragma unroll 1
            for (int ks = 0; ks < 4; ++ks) { const int k0 = wave * 128 + ks * 32 + 8 * fq;
                float wv[8];
#pragma unroll
                for (int j = 0; j < 8; ++j) wv[j] = p.in[I_WADA][(size_t)(k0 + j) * 3072 + c0 + fr];
                bf16x8 bfrag; { u32x4 t; t.x = pk2(wv[0], wv[1]); t.y = pk2(wv[2], wv[3]); t.z = pk2(wv[4], wv[5]); t.w = pk2(wv[6], wv[7]); bfrag = __builtin_bit_cast(bf16x8, t); }
#pragma unroll
                for (int rt = 0; rt < 9; ++rt) { int r = rt * 16 + fr; r = r < 136 ? r : 135;
                    const float* cr = (r < 8 ? p.in[I_CP] + r * 1024 : p.in[I_CS] + (r - 8) * 1024) + k0;
                    const f32x4 c0v = *(const f32x4*)cr, c1v = *(const f32x4*)(cr + 4);
                    u32x4 t; t.x = pk2(silu(c0v.x), silu(c0v.y)); t.y = pk2(silu(c0v.z), silu(c0v.w)); t.z = pk2(silu(c1v.x), silu(c1v.y)); t.w = pk2(silu(c1v.z), silu(c1v.w));
                    acc[rt] = MFMA16(__builtin_bit_cast(bf16x8, t), bfrag, acc[rt]); }
            }
#pragma unroll
            for (int rt = 0; rt < 9; ++rt) red[(wave * 9 + rt) * 64 + lane] = acc[rt];
            __syncthreads();
            float* ada = (float*)(p.ws + W_ADA);
            for (int o = tid; o < 9 * 64; o += 512) { const int rt = o >> 6, l = o & 63; f32x4 sum = red[rt * 64 + l];
#pragma unroll
                for (int w = 1; w < 8; ++w) sum += red[(w * 9 + rt) * 64 + l];
                const float bias = p.in[I_BADA][c0 + (l & 15)];
#pragma unroll
                for (int j = 0; j < 4; ++j) { const int r = rt * 16 + 4 * (l >> 4) + j; if (r < 136) ada[(size_t)r * 3072 + c0 + (l & 15)] = sum[j] + bias; } }
            __syncthreads();
        }
    }
}

__device__ __forceinline__ void phase1(const Params& p) {
    const int tid = threadIdx.x, lane = tid & 63, wave = __builtin_amdgcn_readfirstlane(tid >> 6);
    const float* ada = (const float*)(p.ws + W_ADA);
    const int step = gridDim.x * 8;
    int row = blockIdx.x * 8 + wave;
    f32x4 v[4];
    if (row < MT) { const float* xr = row < MP ? p.in[I_XP] + (size_t)row * 1024 : p.in[I_XS] + (size_t)(row - MP) * 1024;
#pragma unroll
        for (int j = 0; j < 4; ++j) v[j] = *(const f32x4*)(xr + 4 * (lane + 64 * j)); }
    while (row < MT) {
        const int nrow = row + step; f32x4 nv[4];
        if (nrow < MT) { const float* xr = nrow < MP ? p.in[I_XP] + (size_t)nrow * 1024 : p.in[I_XS] + (size_t)(nrow - MP) * 1024;
#pragma unroll
            for (int j = 0; j < 4; ++j) nv[j] = *(const f32x4*)(xr + 4 * (lane + 64 * j)); }
        const bool pr = row < MP;
        const int ar = pr ? (row >> 11) : 8 + row - MP;
        bf16_t* hr = pr ? (bf16_t*)p.out + (size_t)row * 1024 : (bf16_t*)(p.ws + W_HNS) + (size_t)(row - MP) * 1024;
        float ss = 0.f;
#pragma unroll
        for (int j = 0; j < 4; ++j) ss += v[j].x * v[j].x + v[j].y * v[j].y + v[j].z * v[j].z + v[j].w * v[j].w;
        ss = wave_sum(ss);
        const float rstd = __builtin_amdgcn_rsqf(ss * (1.f / 1024.f) + EPS);
#pragma unroll
        for (int j = 0; j < 4; ++j) { const int col = 4 * (lane + 64 * j);
            const f32x4 g = *(const f32x4*)(p.in[I_GN] + col), sh = *(const f32x4*)(ada + (size_t)ar * 3072 + col), sc = *(const f32x4*)(ada + (size_t)ar * 3072 + 1024 + col);
            const f32x4 hv = v[j] * rstd * g * (sc + 1.f) + sh;
            u32x2 o; o.x = pk2(hv.x, hv.y); o.y = pk2(hv.z, hv.w);
            *(u32x2*)(hr + col) = o; }
#pragma unroll
        for (int j = 0; j < 4; ++j) v[j] = nv[j];
        row = nrow;
    }
}

__device__ __forceinline__ f32x4 skinny_tile(const bf16_t* A, int lda, const bf16_t* Bt, int ldb, int K, int lane) {
    const int fr = lane & 15, fq = lane >> 4;
    const bf16x8* pa = (const bf16x8*)(A + (size_t)fr * lda + fq * 8);
    const bf16x8* pb = (const bf16x8*)(Bt + (size_t)fr * ldb + fq * 8);
    f32x4 acc = {0.f, 0.f, 0.f, 0.f};
#pragma unroll 16
    for (int s = 0; s < K / 32; ++s) acc = MFMA16(pa[s * 4], pb[s * 4], acc);
    return acc;
}

struct EpiZ {
    static constexpr bool PERM = true, AFTER_DRAIN = false;
    bf16_t* Z;
    __device__ __forceinline__ void operator()(const f32x4 (&acc)[2][2][4][2], const pg8::Unit& u, int wr, int wc, int fr, int fq) const {
        const int row0 = u.pm * 256 + wr * 64 + fr, col0 = u.pn * 256 + (u.pn >= 16 ? 16 : 0) + wc * 32 + 8 * fq;
#pragma unroll
        for (int ai = 0; ai < 2; ++ai)
#pragma unroll
            for (int m = 0; m < 4; ++m) { bf16_t* rowp = Z + (size_t)(row0 + ai * 128 + m * 16) * DIN + col0;
#pragma unroll
                for (int bj = 0; bj < 2; ++bj) { const f32x4 v0 = acc[ai][bj][m][0], v1 = acc[ai][bj][m][1];
                    u32x4 o; o.x = pk2(v0[0], v0[1]); o.y = pk2(v0[2], v0[3]); o.z = pk2(v1[0], v1[1]); o.w = pk2(v1[2], v1[3]);
                    *(u32x4*)(rowp + bj * 128) = o; } }
    }
};
struct EpiY {
    static constexpr bool PERM = false, AFTER_DRAIN = false;
    const float* x; const float* ada; float* y; float* part;
    __device__ __forceinline__ void operator()(const f32x4 (&acc)[2][2][4][2], const pg8::Unit& u, int wr, int wc, int fr, int fq) const {
        const int row0 = u.pm * 256 + wr * 64 + fr, col0 = u.pn * 256 + wc * 32 + 4 * fq, bb = u.pm >> 3;
        f32x4 gv[2][2];
#pragma unroll
        for (int bj = 0; bj < 2; ++bj)
#pragma unroll
            for (int n = 0; n < 2; ++n) gv[bj][n] = *(const f32x4*)(ada + (size_t)bb * 3072 + 2048 + col0 + bj * 128 + n * 16);
#pragma unroll
        for (int ai = 0; ai < 2; ++ai)
#pragma unroll
            for (int m = 0; m < 4; ++m) { const int row = row0 + ai * 128 + m * 16; const float* xr = x + (size_t)row * 1024 + col0; float* yr = y + (size_t)row * 1024 + col0; float ss = 0.f;
#pragma unroll
                for (int bj = 0; bj < 2; ++bj)
#pragma unroll
                    for (int n = 0; n < 2; ++n) { const f32x4 xv = *(const f32x4*)(xr + bj * 128 + n * 16); const f32x4 v = xv + gv[bj][n] * acc[ai][bj][m][n];
                        *(f32x4*)(yr + bj * 128 + n * 16) = v; ss += v.x * v.x + v.y * v.y + v.z * v.z + v.w * v.w; }
                ss += __shfl_xor(ss, 16); ss += __shfl_xor(ss, 32);
                if (fq == 0) part[(size_t)row * 16 + u.pn * 4 + wc] = ss; }
    }
};

__device__ __forceinline__ void phase2(const Params& p, LAS unsigned char* lds) {
    const int tid = threadIdx.x, lane = tid & 63, wave = __builtin_amdgcn_readfirstlane(tid >> 6), fr = lane & 15, fq = lane >> 4;
    const bf16_t* hnp = (const bf16_t*)p.out; const bf16_t* hns = (const bf16_t*)(p.ws + W_HNS); const bf16_t* wt = (const bf16_t*)(p.ws + W_WTIN);
    float* glrp = (float*)(p.ws + W_GLRP); float* zs = (float*)(p.ws + W_ZS);
    for (int i = blockIdx.x * 8 + wave; i < 1024 + 8 * 321; i += gridDim.x * 8) {
        if (i < 1024) { const f32x4 a = skinny_tile(hnp + (size_t)i * 16 * 1024, 1024, wt + (size_t)C_GLR * 1024, 1024, 1024, lane);
#pragma unroll
            for (int j = 0; j < 4; ++j) glrp[(size_t)(i * 16 + 4 * fq + j) * 16 + fr] = a[j];
        } else { const int r = i - 1024, rt = r / 321, ct = r % 321; const f32x4 a = skinny_tile(hns + (size_t)rt * 16 * 1024, 1024, wt + (size_t)ct * 16 * 1024, 1024, 1024, lane);
#pragma unroll
            for (int j = 0; j < 4; ++j) zs[(size_t)(rt * 16 + 4 * fq + j) * DIN + ct * 16 + fr] = a[j]; }
    }
    __syncthreads();
    pg8::Gemm g{hnp, wt, MP, 5120, 1024, 16, 16};
    pg8::StaticOrder S; S.init(MP, 5120, (int)gridDim.x, (int)blockIdx.x);
    EpiZ E{(bf16_t*)(p.ws + W_Z)};
    pg8::gemm_phase<EpiZ, pg8::StaticOrder, false>(lds, g, S, E, nullptr);
    __syncthreads();
}

template <int PASS>
__device__ __forceinline__ void lru_quarter(const Params& p, LAS unsigned char* lds, int b, int n, int q) {
    const int tid = threadIdx.x, lane = tid & 63, wave = __builtin_amdgcn_readfirstlane(tid >> 6), fr = lane & 15, fq = lane >> 4;
    LAS unsigned char* XC = lds;
    LAS float* XCF = (LAS float*)(lds + 17408);
    LAS float* AA = (LAS float*)(lds + 17408 + 32768);
    LAS float* UU = (LAS float*)(lds + 17408 + 65536);
    LAS float* SP = (LAS float*)(lds + 17408 + 98304);
    LAS float* SH = SP + 1024;
    const bf16_t* z = (const bf16_t*)(p.ws + W_Z);
    float* segA = (float*)(p.ws + W_SEGA); float* segH = (float*)(p.ws + W_SEGH);
    bf16_t* mix = (bf16_t*)(p.ws + W_MIX);
    const size_t rowb = (size_t)b * TT;
    const int ch2 = n * 128 + 2 * lane;
    const bf16_t* zb = z + rowb * DIN + C_XA + ch2;
    f32x2 cw[4];
#pragma unroll
    for (int j = 0; j < 4; ++j) cw[j] = *(const f32x2*)(p.in[I_CW] + j * 1024 + ch2);
    const f32x2 cb = *(const f32x2*)(p.in[I_CB] + ch2);
    bf16x8 bx[4], ba[4];
    {
        const bf16_t* wx = (const bf16_t*)(p.ws + W_WTGX) + (size_t)(n * 128 + wave * 16 + fr) * 128 + fq * 8;
        const bf16_t* wa = (const bf16_t*)(p.ws + W_WTGA) + (size_t)(n * 128 + wave * 16 + fr) * 128 + fq * 8;
#pragma unroll
        for (int ks = 0; ks < 4; ++ks) { bx[ks] = *(const bf16x8*)(wx + ks * 32); ba[ks] = *(const bf16x8*)(wa + ks * 32); }
    }
    const int eg = wave * 16 + fr, chg = n * 128 + eg;
    const float bgx = p.in[I_BGX][chg], bga = p.in[I_BGA][chg], c8 = 8.f * logsig(p.in[I_LAM][chg]);
    f32x2 hc = {0.f, 0.f}, Pq = {1.f, 1.f};
    if (PASS == 2) {
        f32x2 A3[3], H3[3];
#pragma unroll
        for (int qq = 0; qq < 3; ++qq) { A3[qq] = (f32x2){0.f, 0.f}; H3[qq] = (f32x2){0.f, 0.f};
            if (qq < q) { A3[qq] = *(const f32x2*)(segA + (size_t)(b * 4 + qq) * 1024 + ch2); H3[qq] = *(const f32x2*)(segH + (size_t)(b * 4 + qq) * 1024 + ch2); } }
#pragma unroll
        for (int qq = 0; qq < 3; ++qq) if (qq < q) hc = A3[qq] * hc + H3[qq];
    }
    unsigned xraw[11];
    {
        const int tb = q * 512 + wave * 8 - 3;
#pragma unroll
        for (int i = 0; i < 11; ++i) { const int t = tb + i; xraw[i] = (t >= 0) ? *(const unsigned*)(zb + (size_t)t * DIN) : 0u; }
    }
#pragma unroll 1
    for (int seg = 0; seg < 8; ++seg) {
        const int t0 = q * 512 + seg * 64;
        {
            f32x2 xv[11];
#pragma unroll
            for (int i = 0; i < 11; ++i) { xv[i].x = bflo(xraw[i]); xv[i].y = bfhi(xraw[i]); }
#pragma unroll
            for (int r = 0; r < 8; ++r) { const f32x2 xc = cb + cw[0] * xv[r] + cw[1] * xv[r + 1] + cw[2] * xv[r + 2] + cw[3] * xv[r + 3]; const int row = wave * 8 + r;
                *(LAS f32x2*)(XCF + row * 128 + 2 * lane) = xc; *(LAS unsigned*)(XC + row * 272 + lane * 4) = pk2(xc.x, xc.y); }
            if (PASS == 2 && q == 3 && seg == 7 && wave == 7) {
#pragma unroll
                for (int j = 0; j < 3; ++j) *(f32x2*)(p.out + O_CP + (size_t)b * 3072 + j * 1024 + ch2) = xv[8 + j]; }
            if (seg < 7) {
                const int tb = t0 + 64 + wave * 8 - 3;
#pragma unroll
                for (int i = 0; i < 11; ++i) xraw[i] = *(const unsigned*)(zb + (size_t)(tb + i) * DIN);
            }
        }
        unsigned zraw[8];
        if (PASS == 2) {
#pragma unroll
            for (int r = 0; r < 8; ++r) zraw[r] = *(const unsigned*)(z + (rowb + t0 + wave * 8 + r) * DIN + C_ZA + ch2);
        }
        __syncthreads();
        f32x4 ax[4], aa[4];
#pragma unroll
        for (int rt = 0; rt < 4; ++rt) { ax[rt] = (f32x4){0.f, 0.f, 0.f, 0.f}; aa[rt] = (f32x4){0.f, 0.f, 0.f, 0.f}; }
#pragma unroll
        for (int rt = 0; rt < 4; ++rt)
#pragma unroll
            for (int ks = 0; ks < 4; ++ks) { const bf16x8 a = *(const LAS bf16x8*)(XC + (rt * 16 + fr) * 272 + ks * 64 + fq * 16); ax[rt] = MFMA16(a, bx[ks], ax[rt]); aa[rt] = MFMA16(a, ba[ks], aa[rt]); }
#pragma unroll
        for (int rt = 0; rt < 4; ++rt)
#pragma unroll
            for (int j = 0; j < 4; ++j) { const int row = rt * 16 + 4 * fq + j; const float gx = sigm(ax[rt][j] + bgx), ga = sigm(aa[rt][j] + bga), a = __expf(c8 * ga);
                AA[row * 128 + eg] = a; UU[row * 128 + eg] = __builtin_amdgcn_sqrtf(fmaxf(1.f - a * a, 0.f)) * gx * XCF[row * 128 + eg]; }
        __syncthreads();
        {
            f32x2 P = {1.f, 1.f}, H = {0.f, 0.f};
#pragma unroll
            for (int r = 0; r < 8; ++r) { const f32x2 a = *(const LAS f32x2*)(AA + (wave * 8 + r) * 128 + 2 * lane), u = *(const LAS f32x2*)(UU + (wave * 8 + r) * 128 + 2 * lane); H = a * H + u; P = P * a; }
            *(LAS f32x2*)(SP + wave * 128 + 2 * lane) = P; *(LAS f32x2*)(SH + wave * 128 + 2 * lane) = H;
            __syncthreads();
            f32x2 hs = hc;
            f32x2 he = hc;
#pragma unroll
            for (int w = 0; w < 8; ++w) { const f32x2 sp = *(const LAS f32x2*)(SP + w * 128 + 2 * lane), sh = *(const LAS f32x2*)(SH + w * 128 + 2 * lane);
                he = sp * he + sh; if (w < wave) hs = he; if (PASS == 1) Pq = Pq * sp; }
            if (PASS == 2) {
#pragma unroll
                for (int r = 0; r < 8; ++r) { const int row = wave * 8 + r;
                    const f32x2 a = *(const LAS f32x2*)(AA + row * 128 + 2 * lane), u = *(const LAS f32x2*)(UU + row * 128 + 2 * lane);
                    hs = a * hs + u;
                    *(unsigned*)(mix + (rowb + t0 + row) * 2048 + ch2) = pk2(hs.x * silu(bflo(zraw[r])), hs.y * silu(bfhi(zraw[r]))); }
            }
            hc = he;
        }
        __syncthreads();
    }
    if (PASS == 1) { if (wave == 0) { *(f32x2*)(segA + (size_t)(b * 4 + q) * 1024 + ch2) = Pq; *(f32x2*)(segH + (size_t)(b * 4 + q) * 1024 + ch2) = hc; } }
    else if (q == 3 && wave == 0) *(f32x2*)(p.out + O_HP + (size_t)b * 1024 + ch2) = hc;
}

template <int PASS>
__device__ __forceinline__ void gla_item(const Params& p, LAS unsigned char* lds, int b, int h, int seg) {
    const int tid0 = threadIdx.x, lane = tid0 & 63, wave = __builtin_amdgcn_readfirstlane(tid0 >> 6), fr0 = lane & 15, fq0 = lane >> 4;
    int tid = tid0, fr = fr0, fq = fq0;
    LAS unsigned char* QI = lds;
    LAS unsigned char* KI = lds + 8704;
    LAS unsigned char* KDT = lds + 17408;
    LAS unsigned char* VT = lds + 27648;
    LAS unsigned char* AM = lds + 48128;
    LAS unsigned char* ST = lds + 50688;
    LAS float* GLR = (LAS float*)(lds + 120320);
    LAS float* PT = (LAS float*)(lds + 122368);
    LAS float* DEC = (LAS float*)(lds + 126464);
    LAS float* RSS = (LAS float*)(lds + 126976);
    const bf16_t* z = (const bf16_t*)(p.ws + W_Z);
    const float* glrp = (const float*)(p.ws + W_GLRP);
    float* Sloc = p.out + O_SLOC; float* Dseg = (float*)(p.ws + W_DSEG);
    bf16_t* mix = (bf16_t*)(p.ws + W_MIX);
    const int bh = b * 4 + h; int kk0 = 2 * lane;
    LAS float* WG = (LAS float*)(lds + 127488);
    for (int i = tid; i < 2048; i += 512) WG[i] = p.in[I_WG2][(i >> 7) * 512 + h * 128 + (i & 127)];
    const f32x2 bg = *(const f32x2*)(p.in[I_BG2] + h * 128 + kk0);
    f32x4 S[2][8];
#pragma unroll
    for (int a = 0; a < 2; ++a)
#pragma unroll
        for (int k = 0; k < 8; ++k) S[a][k] = (f32x4){0.f, 0.f, 0.f, 0.f};
    f32x2 ltot = {0.f, 0.f};
    if (PASS == 2) {
        for (int s = 0; s < seg; ++s) {
            const float* Sl = Sloc + (size_t)(bh * 8 + s) * 32768; const float* Dv = Dseg + (size_t)(bh * 8 + s) * 128;
#pragma unroll
            for (int kt = 0; kt < 8; ++kt) { const f32x4 d = *(const f32x4*)(Dv + 16 * kt + 4 * fq);
#pragma unroll
                for (int a = 0; a < 2; ++a) S[a][kt] = d * S[a][kt] + *(const f32x4*)(Sl + (size_t)((a * 8 + kt) * 512 + tid) * 4); }
        }
#pragma unroll
        for (int a = 0; a < 2; ++a)
#pragma unroll
            for (int kt = 0; kt < 8; ++kt) { u32x2 o; o.x = pk2(S[a][kt][0], S[a][kt][1]); o.y = pk2(S[a][kt][2], S[a][kt][3]);
                *(LAS u32x2*)(ST + (16 * (2 * wave + a) + fr) * 272 + (16 * kt + 4 * fq) * 2) = o; }
    }
    float glrv; unsigned qv[4], kv[4], vraw[2][4];
#define GLA_LOAD(cc) do { const size_t r0_ = (size_t)b * TT + seg * 256 + (cc) * 32; glrv = glrp[r0_ * 16 + tid0]; \
        _Pragma("unroll") for (int r = 0; r < 4; ++r) { const bf16_t* zr = z + (r0_ + 4 * wave + r) * DIN + h * 128 + 2 * lane; kv[r] = *(const unsigned*)(zr + C_K); qv[r] = (PASS == 2) ? *(const unsigned*)(zr + C_Q) : 0u; } \
        _Pragma("unroll") for (int i = 0; i < 2; ++i) { const int idx = tid0 + i * 512, vp = idx & 127, tg = idx >> 7; \
            _Pragma("unroll") for (int r = 0; r < 4; ++r) vraw[i][r] = *(const unsigned*)(z + (r0_ + 4 * tg + r) * DIN + C_V + h * 256 + 2 * vp); } } while (0)
    GLA_LOAD(0);
    for (int c = 0; c < 8; ++c) {
        tid = tid0; fr = fr0; fq = fq0; kk0 = 2 * lane;
        asm volatile("" : "+v"(tid), "+v"(fr), "+v"(fq), "+v"(kk0));
        const size_t row0 = (size_t)b * TT + seg * 256 + c * 32;
        GLR[tid] = glrv;
        __syncthreads();
        f32x2 cs[4];
        {
            f32x2 run = {0.f, 0.f};
#pragma unroll
            for (int r = 0; r < 4; ++r) { f32x2 x = bg;
#pragma unroll
                for (int q4 = 0; q4 < 4; ++q4) { const f32x4 g = *(const LAS f32x4*)(GLR + (4 * wave + r) * 16 + 4 * q4);
                    x += g.x * *(const LAS f32x2*)(WG + (4 * q4) * 128 + kk0) + g.y * *(const LAS f32x2*)(WG + (4 * q4 + 1) * 128 + kk0)
                       + g.z * *(const LAS f32x2*)(WG + (4 * q4 + 2) * 128 + kk0) + g.w * *(const LAS f32x2*)(WG + (4 * q4 + 3) * 128 + kk0); }
                run.x += logsig_fast(x.x) * 0.0625f; run.y += logsig_fast(x.y) * 0.0625f; cs[r] = run; }
            *(LAS f32x2*)(PT + wave * 128 + kk0) = run;
        }
        __syncthreads();
        f32x2 off = {0.f, 0.f}, tot = {0.f, 0.f};
#pragma unroll
        for (int w = 0; w < 8; ++w) { const f32x2 t = *(const LAS f32x2*)(PT + w * 128 + kk0); tot += t; if (w < wave) off += t; }
        ltot += tot;
        if (wave == 0) { f32x2 d; d.x = __expf(tot.x); d.y = __expf(tot.y); *(LAS f32x2*)(DEC + kk0) = d; }
        {
            float kdx[4], kdy[4];
#pragma unroll
            for (int r = 0; r < 4; ++r) { const f32x2 bb = off + cs[r]; const float k0 = bflo(kv[r]), k1 = bfhi(kv[r]);
                kdx[r] = k0 * __expf(tot.x - bb.x); kdy[r] = k1 * __expf(tot.y - bb.y);
                if (PASS == 2) { const float q0 = bflo(qv[r]) * 0.08838834764831845f, q1 = bfhi(qv[r]) * 0.08838834764831845f;
                    *(LAS unsigned*)(QI + (4 * wave + r) * 272 + kk0 * 2) = pk2(q0 * __expf(bb.x), q1 * __expf(bb.y));
                    *(LAS unsigned*)(KI + (4 * wave + r) * 272 + kk0 * 2) = pk2(k0 * __expf(-bb.x), k1 * __expf(-bb.y)); } }
            u32x2 o; o.x = pk2(kdx[0], kdx[1]); o.y = pk2(kdx[2], kdx[3]); *(LAS u32x2*)(KDT + kk0 * 80 + wave * 8) = o;
            o.x = pk2(kdy[0], kdy[1]); o.y = pk2(kdy[2], kdy[3]); *(LAS u32x2*)(KDT + (kk0 + 1) * 80 + wave * 8) = o;
        }
#pragma unroll
        for (int i = 0; i < 2; ++i) { const int idx = tid + i * 512, vp = idx & 127, tg = idx >> 7;
            u32x2 lo, hi;
            lo.x = (vraw[i][0] & 0xffffu) | (vraw[i][1] << 16); lo.y = (vraw[i][2] & 0xffffu) | (vraw[i][3] << 16);
            hi.x = (vraw[i][0] >> 16) | (vraw[i][1] & 0xffff0000u); hi.y = (vraw[i][2] >> 16) | (vraw[i][3] & 0xffff0000u);
            *(LAS u32x2*)(VT + (2 * vp) * 80 + tg * 8) = lo; *(LAS u32x2*)(VT + (2 * vp + 1) * 80 + tg * 8) = hi; }
        if (c < 7) GLA_LOAD(c + 1);
        __syncthreads();
        const int ct = wave >> 2;
        f32x4 o4[4];
        if (PASS == 2) {
            if (wave < 4) {
                const int st = wave >> 1, cti = wave & 1;
                f32x4 am = {0.f, 0.f, 0.f, 0.f};
#pragma unroll
                for (int ks = 0; ks < 4; ++ks) { const bf16x8 ka = *(const LAS bf16x8*)(KI + (16 * st + fr) * 272 + ks * 64 + fq * 16), qb = *(const LAS bf16x8*)(QI + (16 * cti + fr) * 272 + ks * 64 + fq * 16);
                    am = MFMA16(ka, qb, am); }
                const int cc = 16 * cti + fr; float m[4];
#pragma unroll
                for (int j = 0; j < 4; ++j) m[j] = (16 * st + 4 * fq + j <= cc) ? am[j] : 0.f;
                u32x2 o; o.x = pk2(m[0], m[1]); o.y = pk2(m[2], m[3]);
                *(LAS u32x2*)(AM + cc * 80 + (16 * st + 4 * fq) * 2) = o;
            }
            __syncthreads();
            const bf16x8 amf = *(const LAS bf16x8*)(AM + (16 * ct + fr) * 80 + fq * 16);
            float ss = 0.f;
#pragma unroll
            for (int i = 0; i < 4; ++i) { const int vt = 4 * (wave & 3) + i;
                const bf16x8 vf = *(const LAS bf16x8*)(VT + (16 * vt + fr) * 80 + fq * 16); o4[i] = MFMA16(vf, amf, ((f32x4){0.f, 0.f, 0.f, 0.f})); }
#pragma unroll
            for (int ks = 0; ks < 4; ++ks) { const bf16x8 qf = *(const LAS bf16x8*)(QI + (16 * ct + fr) * 272 + ks * 64 + fq * 16);
#pragma unroll
                for (int i = 0; i < 4; ++i) { const int vt = 4 * (wave & 3) + i; const bf16x8 sf = *(const LAS bf16x8*)(ST + (16 * vt + fr) * 272 + ks * 64 + fq * 16); o4[i] = MFMA16(sf, qf, o4[i]); } }
#pragma unroll
            for (int i = 0; i < 4; ++i) ss += o4[i].x * o4[i].x + o4[i].y * o4[i].y + o4[i].z * o4[i].z + o4[i].w * o4[i].w;
            ss += __shfl_xor(ss, 16); ss += __shfl_xor(ss, 32);
            if (fq == 0) RSS[(16 * ct + fr) * 4 + (wave & 3)] = ss;
            __syncthreads();
            const int cc = 16 * ct + fr; const f32x4 r4 = *(const LAS f32x4*)(RSS + cc * 4);
            const float rstd = 1.0f / sqrtf((r4.x + r4.y + r4.z + r4.w) * (1.f / 256.f) + EPS);
            const size_t row = row0 + cc;
#pragma unroll
            for (int i = 0; i < 4; ++i) { const int col = h * 256 + 16 * (4 * (wave & 3) + i) + 4 * fq;
                const f32x4 g = *(const f32x4*)(p.in[I_GGLA] + col); const u32x2 zg = *(const u32x2*)(z + row * DIN + C_ZG + col);
                u32x2 o; o.x = pk2(o4[i].x * rstd * g.x * silu(bflo(zg.x)), o4[i].y * rstd * g.y * silu(bfhi(zg.x)));
                o.y = pk2(o4[i].z * rstd * g.z * silu(bflo(zg.y)), o4[i].w * rstd * g.w * silu(bfhi(zg.y)));
                *(u32x2*)(mix + row * 2048 + 1024 + col) = o; }
        }
        {
            bf16x8 vf[2];
#pragma unroll
            for (int a = 0; a < 2; ++a) vf[a] = *(const LAS bf16x8*)(VT + (16 * (2 * wave + a) + fr) * 80 + fq * 16);
#pragma unroll
            for (int kt = 0; kt < 8; ++kt) { const f32x4 d = *(const LAS f32x4*)(DEC + 16 * kt + 4 * fq); const bf16x8 kf = *(const LAS bf16x8*)(KDT + (16 * kt + fr) * 80 + fq * 16);
#pragma unroll
                for (int a = 0; a < 2; ++a) S[a][kt] = MFMA16(kf, vf[a], S[a][kt] * d); }
        }
        if (PASS == 2) {
#pragma unroll
            for (int a = 0; a < 2; ++a)
#pragma unroll
                for (int kt = 0; kt < 8; ++kt) { u32x2 o; o.x = pk2(S[a][kt][0], S[a][kt][1]); o.y = pk2(S[a][kt][2], S[a][kt][3]);
                    *(LAS u32x2*)(ST + (16 * (2 * wave + a) + fr) * 272 + (16 * kt + 4 * fq) * 2) = o; }
        }
        __syncthreads();
    }
    if (PASS == 1) {
        float* Sl = Sloc + (size_t)(bh * 8 + seg) * 32768;
#pragma unroll
        for (int a = 0; a < 2; ++a)
#pragma unroll
            for (int kt = 0; kt < 8; ++kt) *(f32x4*)(Sl + (size_t)((a * 8 + kt) * 512 + tid) * 4) = S[a][kt];
        if (wave == 0) { f32x2 d; d.x = __expf(ltot.x); d.y = __expf(ltot.y); *(f32x2*)(Dseg + (size_t)(bh * 8 + seg) * 128 + kk0) = d; }
    } else if (seg == 7) {
        float* gb = p.out + O_GP + (size_t)bh * 32768 + (size_t)(4 * fq) * 256 + 32 * wave + fr;
#pragma unroll
        for (int kt = 0; kt < 8; ++kt)
#pragma unroll
            for (int j = 0; j < 4; ++j)
#pragma unroll
                for (int a = 0; a < 2; ++a) gb[(16 * kt + j) * 256 + 16 * a] = S[a][kt][j];
    }
}

__device__ __forceinline__ void gla_sample_item(const Params& p, LAS unsigned char* lds, int b, int h) {
    const int tid = threadIdx.x, lane = tid & 63, wave = __builtin_amdgcn_readfirstlane(tid >> 6);
    LAS float* AL = (LAS float*)lds; LAS float* KK = AL + 128; LAS float* QQ = AL + 256; LAS float* OS = AL + 384; LAS float* RS = OS + 2048;
    const float* zs = (const float*)(p.ws + W_ZS) + (size_t)b * DIN;
    if (tid < 128) { const int kk = tid; float x = p.in[I_BG2][h * 128 + kk];
#pragma unroll
        for (int r = 0; r < 16; ++r) x += zs[C_GLR + r] * p.in[I_WG2][r * 512 + h * 128 + kk];
        AL[kk] = __expf(logsig(x) * 0.0625f); KK[kk] = zs[C_K + h * 128 + kk]; QQ[kk] = zs[C_Q + h * 128 + kk] * 0.08838834764831845f; }
    __syncthreads();
    const f32x4 vv = *(const f32x4*)(zs + C_V + h * 256 + 4 * lane);
    const float* S0 = p.in[I_STG] + (size_t)(b * 4 + h) * 32768; float* Sn = p.out + O_GS + (size_t)(b * 4 + h) * 32768;
    f32x4 o = {0.f, 0.f, 0.f, 0.f};
#pragma unroll 8
    for (int i = 0; i < 16; ++i) { const int kk = wave * 16 + i; const f32x4 s = *(const f32x4*)(S0 + kk * 256 + 4 * lane); const f32x4 sn = s * AL[kk] + vv * KK[kk];
        *(f32x4*)(Sn + kk * 256 + 4 * lane) = sn; o += sn * QQ[kk]; }
    *(LAS f32x4*)(OS + wave * 256 + 4 * lane) = o;
    __syncthreads();
    float ov = 0.f;
    if (tid < 256) {
#pragma unroll
        for (int g = 0; g < 8; ++g) ov += OS[g * 256 + tid];
        const float ss = wave_sum(ov * ov); if (lane == 0) RS[wave] = ss; }
    __syncthreads();
    if (tid < 256) { const float rstd = 1.0f / sqrtf((RS[0] + RS[1] + RS[2] + RS[3]) * (1.f / 256.f) + EPS);
        const float y = ov * rstd * p.in[I_GGLA][h * 256 + tid] * silu(zs[C_ZG + h * 256 + tid]);
        ((bf16_t*)(p.ws + W_MIX))[(size_t)(MP + b) * 2048 + 1024 + h * 256 + tid] = f2bf(y); }
    __syncthreads();
}
__device__ __forceinline__ void lru_sample_item(const Params& p, LAS unsigned char* lds, int n, int rg) {
    const int tid = threadIdx.x;
    LAS float* XS = (LAS float*)lds;
    LAS float* RED = XS + 512;
    const float* zsb = (const float*)(p.ws + W_ZS);
    {
        const int r = tid >> 7, d = tid & 127, b = rg * 4 + r, ch = n * 128 + d;
        const float xa = zsb[(size_t)b * DIN + C_XA + ch];
        const float* cv = p.in[I_STC] + (size_t)b * 3072 + ch; const float c0 = cv[0], c1 = cv[1024], c2 = cv[2048];
        const float* cw = p.in[I_CW] + ch;
        XS[r * 128 + d] = p.in[I_CB][ch] + cw[0] * c0 + cw[1024] * c1 + cw[2048] * c2 + cw[3072] * xa;
        float* oc = p.out + O_CS + (size_t)b * 3072 + ch; oc[0] = c1; oc[1024] = c2; oc[2048] = xa;
    }
    __syncthreads();
    {
        const int e = tid & 127, q = tid >> 7;
        float gx[4] = {0.f, 0.f, 0.f, 0.f}, ga[4] = {0.f, 0.f, 0.f, 0.f};
        const float* wx = p.in[I_WGX] + (size_t)n * 16384 + (size_t)(q * 32) * 128 + e; const float* wa = p.in[I_WGA] + (size_t)n * 16384 + (size_t)(q * 32) * 128 + e;
#pragma unroll 8
        for (int d = 0; d < 32; ++d) { const float a = wx[d * 128], c = wa[d * 128];
#pragma unroll
            for (int r = 0; r < 4; ++r) { const float x = XS[r * 128 + q * 32 + d]; gx[r] += x * a; ga[r] += x * c; } }
#pragma unroll
        for (int r = 0; r < 4; ++r) { RED[((q * 2 + 0) * 4 + r) * 128 + e] = gx[r]; RED[((q * 2 + 1) * 4 + r) * 128 + e] = ga[r]; }
    }
    __syncthreads();
    {
        const int r = tid >> 7, e = tid & 127, b = rg * 4 + r, ch = n * 128 + e;
        float sx = p.in[I_BGX][ch], sa = p.in[I_BGA][ch];
#pragma unroll
        for (int q = 0; q < 4; ++q) { sx += RED[((q * 2 + 0) * 4 + r) * 128 + e]; sa += RED[((q * 2 + 1) * 4 + r) * 128 + e]; }
        const float gxv = sigm(sx), gav = sigm(sa), la = 8.f * gav * logsig(p.in[I_LAM][ch]);
        const float hn = __expf(la) * p.in[I_STH][(size_t)b * 1024 + ch] + sqrtf(-expm1f(2.f * la)) * gxv * XS[r * 128 + e];
        p.out[O_HS + (size_t)b * 1024 + ch] = hn;
        ((bf16_t*)(p.ws + W_MIX))[(size_t)(MP + b) * 2048 + ch] = f2bf(hn * silu(zsb[(size_t)b * DIN + C_ZA + ch]));
    }
    __syncthreads();
}

__global__ void __launch_bounds__(512, 2) fwd_kernel(Params p) {
    extern __shared__ __attribute__((aligned(16))) unsigned char shm[];
    LAS unsigned char* lds = (LAS unsigned char*)shm;
    cg::grid_group grid = cg::this_grid();
    const int G = (int)gridDim.x, bid = (int)blockIdx.x, tid = threadIdx.x, lane = tid & 63, wave = __builtin_amdgcn_readfirstlane(tid >> 6);
#ifndef SKIPMASK
#define SKIPMASK 0
#endif
#define PH(k) if (!((SKIPMASK >> (k)) & 1) && p.ph_lo <= (k) && (k) < p.ph_hi)
#define SEAM(k) if (p.ph_lo < (k)) grid.sync()
    PH(0) { phase0(p, lds); }
    PH(1) { SEAM(1); phase1(p); }
    PH(2) { SEAM(2); phase2(p, lds); }
    PH(3) { SEAM(3);
        for (int i = bid; i < 224; i += G) gla_item<1>(p, lds, (i / 7) >> 2, (i / 7) & 3, i % 7);
        __syncthreads();
        for (int i = bid; i < 512; i += G) gla_sample_item(p, lds, i >> 2, i & 3);
        for (int i = bid; i < 256; i += G) lru_sample_item(p, lds, i & 7, i >> 3);
        for (int i = bid; i < 256; i += G) lru_quarter<1>(p, lds, i >> 5, (i >> 2) & 7, i & 3);
    }
    PH(4) { SEAM(4);
        for (int i = bid; i < 256; i += G) gla_item<2>(p, lds, i >> 5, (i >> 3) & 3, i & 7);
        {
            const int fr = lane & 15, fq = lane >> 4;
            const bf16_t* mixs = (const bf16_t*)(p.ws + W_MIX) + (size_t)MP * 2048; const bf16_t* wo = (const bf16_t*)(p.ws + W_WTOUT);
            const float* ada = (const float*)(p.ws + W_ADA); float* parts = (float*)(p.ws + W_PARTS);
            for (int i = wave * G + bid; i < 512; i += G * 8) { const int rt = i >> 6, ct = i & 63;
                const f32x4 a = skinny_tile(mixs + (size_t)rt * 16 * 2048, 2048, wo + (size_t)ct * 16 * 2048, 2048, 2048, lane);
#pragma unroll
                for (int j = 0; j < 4; ++j) { const int r = rt * 16 + 4 * fq + j, c = ct * 16 + fr;
                    const float v = p.in[I_XS][(size_t)r * 1024 + c] + ada[(size_t)(8 + r) * 3072 + 2048 + c] * a[j];
                    ((float*)(p.ws + W_ZS))[(size_t)r * 1024 + c] = v;
                    float ss = v * v; ss += __shfl_xor(ss, 1); ss += __shfl_xor(ss, 2); ss += __shfl_xor(ss, 4); ss += __shfl_xor(ss, 8);
                    if (fr == 0) parts[r * 64 + ct] = ss; }
            }
        }
        __syncthreads();
        for (int i = bid; i < 256; i += G) lru_quarter<2>(p, lds, i >> 5, (i >> 2) & 7, i & 3);
    }
    PH(5) { SEAM(5);
        __syncthreads();
        pg8::Gemm g{(const bf16_t*)(p.ws + W_MIX), (const bf16_t*)(p.ws + W_WTOUT), MP, 1024, 2048, 1 << 30, 0};
        pg8::StaticOrder S; S.init(MP, 1024, G, bid);
        EpiY E{p.in[I_XP], (const float*)(p.ws + W_ADA), (float*)(p.ws + W_Z), (float*)(p.ws + W_PART)};
        pg8::gemm_phase<EpiY, pg8::StaticOrder, false>(lds, g, S, E, nullptr);
    }
    PH(6) { SEAM(6);
        const float* part = (const float*)(p.ws + W_PART); const float* parts = (const float*)(p.ws + W_PARTS);
        const int step = G * 8; int row = bid * 8 + wave;
        f32x4 v[4]; float ps = 0.f;
        if (row < MT) { const float* yr = row < MP ? (const float*)(p.ws + W_Z) + (size_t)row * 1024 : (const float*)(p.ws + W_ZS) + (size_t)(row - MP) * 1024;
#pragma unroll
            for (int j = 0; j < 4; ++j) v[j] = *(const f32x4*)(yr + 4 * (lane + 64 * j));
            ps = row < MP ? (lane < 16 ? part[(size_t)row * 16 + lane] : 0.f) : parts[(row - MP) * 64 + lane]; }
        while (row < MT) {
            const int nrow = row + step; f32x4 nv[4]; float nps = 0.f;
            if (nrow < MT) { const float* yr = nrow < MP ? (const float*)(p.ws + W_Z) + (size_t)nrow * 1024 : (const float*)(p.ws + W_ZS) + (size_t)(nrow - MP) * 1024;
#pragma unroll
                for (int j = 0; j < 4; ++j) nv[j] = *(const f32x4*)(yr + 4 * (lane + 64 * j));
                nps = nrow < MP ? (lane < 16 ? part[(size_t)nrow * 16 + lane] : 0.f) : parts[(nrow - MP) * 64 + lane]; }
            const float rstd = __builtin_amdgcn_rsqf(wave_sum(ps) * (1.f / 1024.f) + EPS);
            float* yr = p.out + (size_t)row * 1024;
#pragma unroll
            for (int j = 0; j < 4; ++j) { const int col = 4 * (lane + 64 * j); const f32x4 g = *(const f32x4*)(p.in[I_GFIN] + col); *(f32x4*)(yr + col) = v[j] * rstd * g; }
#pragma unroll
            for (int j = 0; j < 4; ++j) v[j] = nv[j];
            ps = nps; row = nrow;
        }
    }
}

#ifndef N_LAUNCH
#define N_LAUNCH 1
#endif
extern "C" void kernel_launch(void* const* d_in, const int* in_sizes, int n_in, void* d_out, int out_size, void* d_ws, size_t ws_size, hipStream_t stream) {
    static int grid = 0;
    if (grid == 0) {
        int dev = 0, cus = 0, per_cu = 0;
        if (n_in != N_IN || ws_size < W_END) { fprintf(stderr, "kernel_launch: unexpected problem: n_in %d ws %zu (need %zu)\n", n_in, ws_size, (size_t)W_END); grid = -1; return; }
        hipGetDevice(&dev); hipDeviceGetAttribute(&cus, hipDeviceAttributeMultiprocessorCount, dev);
        if (hipFuncSetAttribute((const void*)fwd_kernel, hipFuncAttributeMaxDynamicSharedMemorySize, LDS_BYTES) != hipSuccess) { fprintf(stderr, "kernel_launch: hipFuncSetAttribute failed\n"); grid = -1; return; }
        if (hipOccupancyMaxActiveBlocksPerMultiprocessor(&per_cu, (const void*)fwd_kernel, 512, LDS_BYTES) != hipSuccess || per_cu < 1) { fprintf(stderr, "kernel_launch: occupancy query says %d blocks per CU\n", per_cu); (void)hipGetLastError(); grid = -1; return; }
        grid = cus;
    }
    if (grid < 0) return;
    Params p; memset(&p, 0, sizeof(p));
    for (int i = 0; i < N_IN; ++i) p.in[i] = (const float*)d_in[i];
    p.out = (float*)d_out; p.ws = (unsigned char*)d_ws;
#ifdef PROBE_SEQ
    { const int seq[] = PROBE_SEQ; for (int ph : seq) { p.ph_lo = ph; p.ph_hi = ph + 1; hipLaunchKernelGGL(fwd_kernel, dim3(grid), dim3(512), LDS_BYTES, stream, p); } }
#elif N_LAUNCH == 1
    p.ph_lo = 0; p.ph_hi = 7;
    void* args[] = {&p};
    hipError_t e = hipLaunchCooperativeKernel((const void*)fwd_kernel, dim3(grid), dim3(512), args, LDS_BYTES, stream);
    if (e != hipSuccess) fprintf(stderr, "kernel_launch: cooperative launch failed: %s (grid %d)\n", hipGetErrorString(e), grid);
#else
    for (int ph = 0; ph < 7; ++ph) { p.ph_lo = ph; p.ph_hi = ph + 1; hipLaunchKernelGGL(fwd_kernel, dim3(grid), dim3(512), LDS_BYTES, stream, p); }
#endif
}
```
